# Optimizing an MI355X kernel written in HIP

```python
import math
import jax
import jax.numpy as jnp
from jax import lax
import numpy as np

D_MODEL = 1024
BATCH = 8
SEQ = 4096
DEPTH = 4
DEC_BATCH = 16
DEC_SEQ = 16
PAST_LEN = 1024

CHUNK = 64
Q_BLOCK = 128
N_EVEN = (DEPTH + 1) // 2
N_ODD = DEPTH // 2
D_FF = ((8 * D_MODEL // 3 + 127) // 128) * 128
EPS = 1e-6
NEG_INF = -1e30
LRU_W = D_MODEL // 2
LRU_BLOCKS = 8
LRU_BLOCK = LRU_W // LRU_BLOCKS
LRU_C = 8.0
CONV_W = 4
FOX_HEADS = 8
FOX_DH = (D_MODEL // 2) // FOX_HEADS
FOX_W = FOX_HEADS * FOX_DH
EVEN_MIX_W = LRU_W + FOX_W
EVEN_PROJ = 2 * LRU_W + 3 * FOX_W + FOX_HEADS
DIFF_HEADS = 8
DIFF_DH = D_MODEL // (2 * DIFF_HEADS)
DIFF_W = DIFF_HEADS * 2 * DIFF_DH
ROT_DIM = DIFF_DH // 4
ROPE_THETA = 500000.0

kernel_name = 'streaming_hybrid_rglru_fox_diffattn_step'


def _rmsnorm(x, g):
    xf = x.astype(jnp.float32)
    y = xf * lax.rsqrt(jnp.mean(xf * xf, axis=-1, keepdims=True) + EPS)
    return (y * g.astype(jnp.float32)).astype(x.dtype)


def _swiglu(x, w_in, w_out):
    g, u = jnp.split(x @ w_in, 2, axis=-1)
    return (jax.nn.silu(g) * u) @ w_out


def _rope(x, pos):
    half = ROT_DIM // 2
    inv = ROPE_THETA ** (-jnp.arange(half, dtype=jnp.float32) * (2.0 / ROT_DIM))
    ang = pos.astype(jnp.float32)[:, None] * inv[None, :]
    shape = (ang.shape[0],) + (1,) * (x.ndim - 3) + (half,)
    cos = jnp.cos(ang).reshape(shape).astype(x.dtype)
    sin = jnp.sin(ang).reshape(shape).astype(x.dtype)
    x1 = x[..., :half]
    x2 = x[..., half:ROT_DIM]
    return jnp.concatenate([x1 * cos - x2 * sin, x2 * cos + x1 * sin, x[..., ROT_DIM:]], axis=-1)


def _over_query_blocks(fn, qpos, *qs):
    T = qpos.shape[0]
    if T <= Q_BLOCK:
        return fn(qpos, *qs)
    nb = T // Q_BLOCK

    def split(a):
        return jnp.moveaxis(a.reshape(a.shape[0], nb, Q_BLOCK, *a.shape[2:]), 1, 0)

    out = lax.map(lambda args: fn(args[0], *args[1:]),
                  (qpos.reshape(nb, Q_BLOCK),) + tuple(split(a) for a in qs))
    out = jnp.moveaxis(out, 0, 1)
    return out.reshape(out.shape[0], T, *out.shape[3:])


def _causal_conv(u, buf, w, b):
    T = u.shape[1]
    full = jnp.concatenate([buf.astype(u.dtype), u], axis=1)
    y = b
    for j in range(CONV_W):
        y = y + full[:, j:j + T] * w[j]
    return y, full[:, T:]


def _rglru(u, h0, w_gates, b_gates, lam):
    B, T, C = u.shape
    ub = u.reshape(B, T, LRU_BLOCKS, LRU_BLOCK)
    gates = (jnp.einsum('btnc,ncg->btng', ub, w_gates) + b_gates).astype(jnp.float32)
    r = jax.nn.sigmoid(gates[..., :LRU_BLOCK]).reshape(B, T, C)
    i = jax.nn.sigmoid(gates[..., LRU_BLOCK:]).reshape(B, T, C)
    log_a = -LRU_C * r * jax.nn.softplus(-lam.astype(jnp.float32))
    a = jnp.exp(log_a)
    bx = jnp.sqrt(-jnp.expm1(2.0 * log_a)) * (i * u.astype(jnp.float32))
    bx = bx.at[:, 0].add(a[:, 0] * h0.astype(jnp.float32))

    def combine(left, right):
        a_l, b_l = left
        a_r, b_r = right
        return a_l * a_r, a_r * b_l + b_r

    _, h = lax.associative_scan(combine, (a, bx), axis=1)
    return h, h[:, -1]


def _even_mixer(h, pos, fk_past, fv_past, flogf_past, lru_h0, lru_buf,
                w_in, b_f, conv_w, conv_b, w_gates, b_gates, lam, w_out):
    B, T, _ = h.shape
    cuts = [LRU_W, 2 * LRU_W, 2 * LRU_W + FOX_W, 2 * LRU_W + 2 * FOX_W, 2 * LRU_W + 3 * FOX_W]
    u, gate, q, k, v, f_logit = jnp.split(h @ w_in, cuts, axis=-1)
    uc, new_buf = _causal_conv(u, lru_buf, conv_w, conv_b)
    hs, h_last = _rglru(uc, lru_h0, w_gates, b_gates, lam)
    y_a = hs.astype(h.dtype) * jax.nn.gelu(gate)
    q = q.reshape(B, T, FOX_HEADS, FOX_DH) * (FOX_DH ** -0.5)
    k = k.reshape(B, T, FOX_HEADS, FOX_DH)
    v = v.reshape(B, T, FOX_HEADS, FOX_DH)
    logf = jax.nn.log_sigmoid((f_logit + b_f).astype(jnp.float32))
    P = fk_past.shape[1]
    k_all = jnp.concatenate([fk_past.astype(k.dtype), k], axis=1)
    v_all = jnp.concatenate([fv_past.astype(v.dtype), v], axis=1)
    c_all = jnp.cumsum(jnp.concatenate([flogf_past.astype(jnp.float32), logf], axis=1), axis=1)
    c_keys = c_all.transpose(0, 2, 1)[:, :, None, :]
    c_q = c_all[:, P:]
    kpos = jnp.arange(P + T, dtype=jnp.int32)

    def block(qp, qb, cqb):
        s = jnp.einsum('bqhd,bkhd->bhqk', qb, k_all).astype(jnp.float32)
        s = s + cqb.transpose(0, 2, 1)[..., None] - c_keys
        s = jnp.where(qp[:, None] >= kpos[None, :], s, NEG_INF)
        p = jax.nn.softmax(s, axis=-1).astype(v_all.dtype)
        return jnp.einsum('bhqk,bkhd->bqhd', p, v_all)

    y_b = _over_query_blocks(block, pos, q, c_q).reshape(B, T, FOX_W)
    out = jnp.concatenate([y_a, y_b], axis=-1) @ w_out
    return out, (k, v, logf.astype(h.dtype), h_last.astype(h.dtype), new_buf)


def _diff_mixer(h, pos, dk_past, dv_past, w_in, lam_params, subln_g, w_out, lam_init):
    B, T, _ = h.shape
    q, k, v = jnp.split(h @ w_in, 3, axis=-1)
    q = _rope(q.reshape(B, T, DIFF_HEADS, 2, DIFF_DH), pos) * (DIFF_DH ** -0.5)
    k = _rope(k.reshape(B, T, DIFF_HEADS, 2, DIFF_DH), pos)
    v = v.reshape(B, T, DIFF_HEADS, 2 * DIFF_DH)
    P = dk_past.shape[1]
    k_all = jnp.concatenate([dk_past.astype(k.dtype).reshape(B, P, DIFF_HEADS, 2, DIFF_DH), k], axis=1)
    v_all = jnp.concatenate([dv_past.astype(v.dtype), v], axis=1)
    lp = lam_params.astype(jnp.float32)
    lam = jnp.exp(jnp.sum(lp[0] * lp[1])) - jnp.exp(jnp.sum(lp[2] * lp[3])) + lam_init
    kchunk = jnp.arange(P + T, dtype=jnp.int32) // CHUNK

    def block(qp, qb):
        s = jnp.einsum('bqhcd,bkhcd->bhcqk', qb, k_all).astype(jnp.float32)
        s = jnp.where((qp // CHUNK)[:, None] >= kchunk[None, :], s, NEG_INF)
        p = jax.nn.softmax(s, axis=-1)
        a = (p[:, :, 0] - lam * p[:, :, 1]).astype(v_all.dtype)
        return jnp.einsum('bhqk,bkhd->bqhd', a, v_all)

    o = _over_query_blocks(block, pos, q)
    o = _rmsnorm(o, subln_g) * (1.0 - lam_init)
    out = o.reshape(B, T, DIFF_W) @ w_out
    return out, (k.reshape(B, T, DIFF_HEADS, 2 * DIFF_DH), v)


def _trunk(x, pos, fox_k, fox_v, fox_logf, lru_h, lru_conv, diff_k, diff_v,
           norm_g, w_ffn_in, w_ffn_out, w_in_even, b_fox_f, lru_conv_w, lru_conv_b,
           lru_w_gates, lru_b_gates, lru_lambda, w_out_even, w_in_odd, diff_lambda,
           diff_subln_g, w_out_odd):
    new_even, new_odd = [], []
    for l in range(DEPTH):
        g = norm_g[l]
        x = x + 0.5 * _rmsnorm(_swiglu(_rmsnorm(x, g[0]), w_ffn_in[l, 0], w_ffn_out[l, 0]), g[1])
        hn = _rmsnorm(x, g[2])
        if l % 2 == 0:
            e = l // 2
            m, st = _even_mixer(hn, pos, fox_k[e], fox_v[e], fox_logf[e], lru_h[e], lru_conv[e],
                                w_in_even[e], b_fox_f[e], lru_conv_w[e], lru_conv_b[e],
                                lru_w_gates[e], lru_b_gates[e], lru_lambda[e], w_out_even[e])
            new_even.append(st)
        else:
            o = l // 2
            lam_init = 0.8 - 0.6 * math.exp(-0.3 * l)
            m, st = _diff_mixer(hn, pos, diff_k[o], diff_v[o], w_in_odd[o], diff_lambda[o],
                                diff_subln_g[o], w_out_odd[o], lam_init)
            new_odd.append(st)
        x = x + _rmsnorm(m, g[3])
        x = x + 0.5 * _rmsnorm(_swiglu(_rmsnorm(x, g[4]), w_ffn_in[l, 1], w_ffn_out[l, 1]), g[5])
    even = [jnp.stack(z) for z in zip(*new_even)]
    odd = [jnp.stack(z) for z in zip(*new_odd)]
    return x, even, odd


def setup_inputs(seed: int = 0) -> dict:
    key = jax.random.key(seed)
    ks = jax.random.split(key, 24)
    nrm = jax.random.normal
    f32 = jnp.float32
    u = jax.random.uniform(ks[18], (N_EVEN, LRU_W), f32, 0.9, 0.999)
    s = u ** (1.0 / LRU_C)
    return {
        'x_prompt': nrm(ks[0], (BATCH, SEQ, D_MODEL), f32),
        'x_sample': nrm(ks[1], (DEC_BATCH, DEC_SEQ, D_MODEL), f32),
        'cache_fox_k': nrm(ks[2], (N_EVEN, DEC_BATCH, PAST_LEN, FOX_HEADS, FOX_DH), f32),
        'cache_fox_v': nrm(ks[3], (N_EVEN, DEC_BATCH, PAST_LEN, FOX_HEADS, FOX_DH), f32),
        'cache_fox_logf': jax.nn.log_sigmoid(2.0 + 0.5 * nrm(ks[4], (N_EVEN, DEC_BATCH, PAST_LEN, FOX_HEADS), f32)),
        'state_lru_h': 0.5 * nrm(ks[5], (N_EVEN, DEC_BATCH, LRU_W), f32),
        'state_lru_conv': nrm(ks[6], (N_EVEN, DEC_BATCH, CONV_W - 1, LRU_W), f32),
        'cache_diff_k': nrm(ks[7], (N_ODD, DEC_BATCH, PAST_LEN, DIFF_HEADS, 2 * DIFF_DH), f32),
        'cache_diff_v': nrm(ks[8], (N_ODD, DEC_BATCH, PAST_LEN, DIFF_HEADS, 2 * DIFF_DH), f32),
        'norm_g': 1.0 + 0.05 * nrm(ks[9], (DEPTH, 6, D_MODEL), f32),
        'w_ffn_in': nrm(ks[10], (DEPTH, 2, D_MODEL, 2 * D_FF), f32) * D_MODEL ** -0.5,
        'w_ffn_out': nrm(ks[11], (DEPTH, 2, D_FF, D_MODEL), f32) * D_FF ** -0.5,
        'w_in_even': nrm(ks[12], (N_EVEN, D_MODEL, EVEN_PROJ), f32) * D_MODEL ** -0.5,
        'b_fox_f': 2.0 + 0.5 * nrm(ks[13], (N_EVEN, FOX_HEADS), f32),
        'lru_conv_w': nrm(ks[14], (N_EVEN, CONV_W, LRU_W), f32) * CONV_W ** -0.5,
        'lru_conv_b': 0.01 * nrm(ks[15], (N_EVEN, LRU_W), f32),
        'lru_w_gates': nrm(ks[16], (N_EVEN, LRU_BLOCKS, LRU_BLOCK, 2 * LRU_BLOCK), f32) * LRU_BLOCK ** -0.5,
        'lru_b_gates': 0.01 * nrm(ks[17], (N_EVEN, LRU_BLOCKS, 2 * LRU_BLOCK), f32),
        'lru_lambda': jnp.log(s) - jnp.log1p(-s),
        'w_out_even': nrm(ks[19], (N_EVEN, EVEN_MIX_W, D_MODEL), f32) * EVEN_MIX_W ** -0.5,
        'w_in_odd': nrm(ks[20], (N_ODD, D_MODEL, 3 * DIFF_W), f32) * D_MODEL ** -0.5,
        'diff_lambda': 0.1 * nrm(ks[21], (N_ODD, 4, DIFF_DH), f32),
        'diff_subln_g': 1.0 + 0.05 * nrm(ks[22], (N_ODD, 2 * DIFF_DH), f32),
        'w_out_odd': nrm(ks[23], (N_ODD, DIFF_W, D_MODEL), f32) * DIFF_W ** -0.5,
    }


def reference(x_prompt, x_sample, cache_fox_k, cache_fox_v, cache_fox_logf, state_lru_h,
              state_lru_conv, cache_diff_k, cache_diff_v, norm_g, w_ffn_in, w_ffn_out,
              w_in_even, b_fox_f, lru_conv_w, lru_conv_b, lru_w_gates, lru_b_gates,
              lru_lambda, w_out_even, w_in_odd, diff_lambda, diff_subln_g, w_out_odd):
    weights = (norm_g, w_ffn_in, w_ffn_out, w_in_even, b_fox_f, lru_conv_w, lru_conv_b,
               lru_w_gates, lru_b_gates, lru_lambda, w_out_even, w_in_odd, diff_lambda,
               diff_subln_g, w_out_odd)
    B, S, _ = x_prompt.shape
    dt = x_prompt.dtype
    y_prompt, pe, po = _trunk(
        x_prompt, jnp.arange(S, dtype=jnp.int32),
        jnp.zeros((N_EVEN, B, 0, FOX_HEADS, FOX_DH), dt),
        jnp.zeros((N_EVEN, B, 0, FOX_HEADS, FOX_DH), dt),
        jnp.zeros((N_EVEN, B, 0, FOX_HEADS), dt),
        jnp.zeros((N_EVEN, B, LRU_W), dt),
        jnp.zeros((N_EVEN, B, CONV_W - 1, LRU_W), dt),
        jnp.zeros((N_ODD, B, 0, DIFF_HEADS, 2 * DIFF_DH), dt),
        jnp.zeros((N_ODD, B, 0, DIFF_HEADS, 2 * DIFF_DH), dt),
        *weights)
    past = cache_fox_k.shape[2]
    T = x_sample.shape[1]
    y_sample, se, so = _trunk(
        x_sample, past + jnp.arange(T, dtype=jnp.int32),
        cache_fox_k, cache_fox_v, cache_fox_logf, state_lru_h, state_lru_conv,
        cache_diff_k, cache_diff_v, *weights)
    p_fox_k, p_fox_v, p_fox_logf, p_lru_h, p_lru_conv = pe
    p_diff_k, p_diff_v = po
    s_fox_k, s_fox_v, s_fox_logf, s_lru_h, s_lru_conv = se
    s_diff_k, s_diff_v = so
    return (y_prompt, y_sample,
            p_fox_k, p_fox_v, p_fox_logf, p_lru_h, p_lru_conv, p_diff_k, p_diff_v,
            s_fox_k, s_fox_v, s_fox_logf, s_lru_h, s_lru_conv, s_diff_k, s_diff_v)
```

```cpp
#include <hip/hip_runtime.h>
#include <hip/hip_cooperative_groups.h>
#include <cstdio>
#include <cstdint>
namespace cg = cooperative_groups;

#ifndef MULTI_LAUNCH
#define MULTI_LAUNCH 0
#endif

#define DI __device__ __forceinline__
#define LDS __attribute__((address_space(3)))
typedef unsigned short bf16_t;
typedef short bf16x8 __attribute__((ext_vector_type(8)));
typedef short s16x4 __attribute__((ext_vector_type(4)));
typedef float f32x16 __attribute__((ext_vector_type(16)));
typedef float f32x4 __attribute__((ext_vector_type(4)));
typedef float f32x2 __attribute__((ext_vector_type(2)));
typedef unsigned u32x4 __attribute__((ext_vector_type(4)));
typedef unsigned u32x2 __attribute__((ext_vector_type(2)));
typedef __bf16 bf2_t __attribute__((ext_vector_type(2)));
#define MFMA(a, b, c) __builtin_amdgcn_mfma_f32_32x32x16_bf16((a), (b), (c), 0, 0, 0)

constexpr int MP = 32768, MS = 256, MT = 33024;
constexpr int DM = 1024, DFF = 2816;
constexpr float LOG2E = 1.4426950408889634f;
constexpr float EPSN = 1e-6f;
constexpr int NT = 512, NW = 8;
constexpr int KVS = 1088;

constexpr size_t OFF_CTRL = 0;
constexpr size_t OFF_BAR = 4096;
constexpr size_t OFF_ROPE = 20480;
constexpr size_t OFF_WT_FFN_IN = OFF_ROPE + 262144;
constexpr size_t OFF_WT_FFN_OUT = OFF_WT_FFN_IN + 92274688;
constexpr size_t OFF_WT_IN_EVEN = OFF_WT_FFN_OUT + 46137344;
constexpr size_t OFF_WT_OUT_EVEN = OFF_WT_IN_EVEN + 11534336;
constexpr size_t OFF_WT_IN_ODD = OFF_WT_OUT_EVEN + 4194304;
constexpr size_t OFF_WT_OUT_ODD = OFF_WT_IN_ODD + 12582912;
constexpr size_t OFF_WT_GATES = OFF_WT_OUT_ODD + 4194304;
constexpr size_t OFF_SACC = OFF_WT_GATES + 524288;
constexpr size_t OFF_HN = OFF_SACC + 1048576;
constexpr size_t OFF_OUT = OFF_HN + 67633152;
constexpr size_t OFF_KS = OFF_OUT + 67633152;
constexpr size_t OFF_VS = OFF_KS + 35651584;
constexpr size_t OFF_R = OFF_VS + 35651584;
constexpr size_t R_ACT = OFF_R;
constexpr size_t R_U = OFF_R;
constexpr size_t R_G = R_U + 67633152;
constexpr size_t R_QE = R_G + 33816576;
constexpr size_t R_KE = R_QE + 33816576;
constexpr size_t R_VE = R_KE + 33554432;
constexpr size_t R_LOGF = R_VE + 33554432;
constexpr size_t R_CBP = R_LOGF + 1056768;
constexpr size_t R_CBS = R_CBP + 1048576;
constexpr size_t R_UC = R_CBS + 557056;
constexpr size_t R_LA = R_UC + 33816576;
constexpr size_t R_IU = R_LA + 67633152;
constexpr size_t R_SEGA = R_IU + 67633152;
constexpr size_t R_SEGB = R_SEGA + 1081344;
constexpr size_t R_EVEN_END = R_SEGB + 1081344;
constexpr size_t R_QO = OFF_R;
constexpr size_t R_KO = R_QO + 67633152;
constexpr size_t R_VO = R_KO + 67108864;
constexpr size_t R_O1 = R_VO + 67108864;
constexpr size_t R_ODD_END = R_O1 + 135266304;
constexpr size_t WS_NEEDED = (R_EVEN_END > R_ODD_END ? R_EVEN_END : R_ODD_END);

constexpr size_t O_Y = 0;
constexpr size_t O_PFK = O_Y + (size_t)MT * 1024;
constexpr size_t O_PFV = O_PFK + 33554432;
constexpr size_t O_PFL = O_PFV + 33554432;
constexpr size_t O_PLH = O_PFL + 524288;
constexpr size_t O_PLC = O_PLH + 8192;
constexpr size_t O_PDK = O_PLC + 24576;
constexpr size_t O_PDV = O_PDK + 67108864;
constexpr size_t O_SFK = O_PDV + 67108864;
constexpr size_t O_SFV = O_SFK + 262144;
constexpr size_t O_SFL = O_SFV + 262144;
constexpr size_t O_SLH = O_SFL + 4096;
constexpr size_t O_SLC = O_SLH + 16384;
constexpr size_t O_SDK = O_SLC + 49152;
constexpr size_t O_SDV = O_SDK + 524288;

enum { I_XP = 0, I_XS, I_CFK, I_CFV, I_CFL, I_SLH, I_SLC, I_CDK, I_CDV, I_NG, I_WFI, I_WFO, I_WIE, I_BFF, I_CW, I_CB, I_WG, I_BG,
       I_LAM, I_WOE, I_WIO, I_DLAM, I_SUBG, I_WOO };

struct Params {
    const float* in[24];
    float* out;
    char* ws;
};

__shared__ __attribute__((aligned(16))) char smem[131072];

DI int tid_opaque() { int t = threadIdx.x; asm volatile("" : "+v"(t)); return t; }
#define TIDX tid_opaque()
DI float bf2f(bf16_t x) { return __uint_as_float(((unsigned)x) << 16); }
DI unsigned pk2(float lo, float hi) { f32x2 v = {lo, hi}; bf2_t b = __builtin_convertvector(v, bf2_t); return __builtin_bit_cast(unsigned, b); }
DI bf16_t f2bf(float x) { return (bf16_t)(pk2(x, 0.f) & 0xffffu); }
DI float wave_sum(float v) {
#pragma unroll
    for (int o = 32; o >= 1; o >>= 1) v += __shfl_xor(v, o);
    return v;
}
DI float sigmoidf_(float x) { return 1.0f / (1.0f + __expf(-x)); }
DI float softplusf_(float x) { return fmaxf(x, 0.f) + log1pf(__expf(-fabsf(x))); }
DI float gelu_tanh(float x) { const float u = 0.7978845608028654f * (x + 0.044715f * x * x * x); return x / (1.0f + __expf(-2.0f * u)); }
DI int crow(int i, int hh) { return (i & 3) + 8 * (i >> 2) + 4 * hh; }

struct WtJob { const float* src; bf16_t* dst; int K, Ns, mode, p0, k0; };
DI WtJob wt_decode(const Params& P, int t) {
    int tt = t, g;
    if (tt < 11264) g = 0; else if ((tt -= 11264) < 5632) g = 1; else if ((tt -= 5632) < 1408) g = 2; else if ((tt -= 1408) < 512) g = 3;
    else if ((tt -= 512) < 1536) g = 4; else { tt -= 1536; g = 5; }
    const float* src; bf16_t* dst; int K = 1024, Ns = 1024, Nd = 1024, mode = 0;
    switch (g) {
        case 0: src = P.in[I_WFI]; dst = (bf16_t*)(P.ws + OFF_WT_FFN_IN); mode = 1; Ns = 5632; Nd = 5632; break;
        case 1: src = P.in[I_WFO]; dst = (bf16_t*)(P.ws + OFF_WT_FFN_OUT); K = 2816; break;
        case 2: src = P.in[I_WIE]; dst = (bf16_t*)(P.ws + OFF_WT_IN_EVEN); Ns = 2568; Nd = 2816; break;
        case 3: src = P.in[I_WOE]; dst = (bf16_t*)(P.ws + OFF_WT_OUT_EVEN); break;
        case 4: src = P.in[I_WIO]; dst = (bf16_t*)(P.ws + OFF_WT_IN_ODD); Ns = 3072; Nd = 3072; break;
        default: src = P.in[I_WOO]; dst = (bf16_t*)(P.ws + OFF_WT_OUT_ODD); break;
    }
    const int npt = Nd / 64, tpm = npt * (K / 64);
    const int mat = tt / tpm, ti = tt % tpm;
    WtJob j; j.src = src + (size_t)mat * K * Ns; j.dst = dst + (size_t)mat * Nd * K; j.K = K; j.Ns = Ns; j.mode = mode; j.p0 = (ti % npt) * 64; j.k0 = (ti / npt) * 64;
    return j;
}
DI void wt_load(const WtJob& j, float (&v)[8]) {
    const int tid = TIDX;
#pragma unroll
    for (int q = 0; q < 8; ++q) {
        const int idx = tid + NT * q, kk = idx >> 6, pp = idx & 63, p = j.p0 + pp;
        int col = p;
        if (j.mode == 1) { const int pn = p >> 8, w = p & 255; col = ((w >> 5) & 1) * DFF + pn * 128 + (w >> 6) * 32 + (w & 31); }
        v[q] = (col < j.Ns) ? j.src[(size_t)(j.k0 + kk) * j.Ns + col] : 0.f;
    }
}
DI void wt_store(const WtJob& j, const float (&v)[8]) {
    float* T = (float*)smem;
    const int tid = TIDX;
#pragma unroll
    for (int q = 0; q < 8; ++q) { const int idx = tid + NT * q; T[(idx >> 6) * 65 + (idx & 63)] = v[q]; }
    __syncthreads();
    {
        const int pp = tid >> 3, ks = (tid & 7) * 8;
        unsigned w[4];
#pragma unroll
        for (int q = 0; q < 4; ++q) w[q] = pk2(T[(ks + 2 * q) * 65 + pp], T[(ks + 2 * q + 1) * 65 + pp]);
        *(u32x4*)(j.dst + (size_t)(j.p0 + pp) * j.K + j.k0 + ks) = (u32x4){w[0], w[1], w[2], w[3]};
    }
    __syncthreads();
}

DI void phase_prologue(const Params& P) {
    const int total = 20864;
    {
        int t = blockIdx.x;
        WtJob job{}; float cur[8];
        if (t < total) { job = wt_decode(P, t); wt_load(job, cur); }
        for (; t < total; t += gridDim.x) {
            const int tn = t + gridDim.x;
            WtJob jobn = job; float nxt[8];
            if (tn < total) { jobn = wt_decode(P, tn); wt_load(jobn, nxt); }
            else {
#pragma unroll
                for (int q = 0; q < 8; ++q) nxt[q] = 0.f;
            }
            wt_store(job, cur);
            job = jobn;
#pragma unroll
            for (int q = 0; q < 8; ++q) cur[q] = nxt[q];
        }
    }
    {
        bf16_t* wgx = (bf16_t*)(P.ws + OFF_WT_GATES);
        const float* wg = P.in[I_WG];
        for (int idx = blockIdx.x * NT + TIDX; idx < 2 * 4 * 256 * 128; idx += gridDim.x * NT) {
            const int k = idx & 127, n = (idx >> 7) & 255, pr = (idx >> 15) & 3, e = idx >> 17;
            float v = 0.f;
            if (n < 128) { if (k < 64) v = wg[((size_t)(e * 8 + 2 * pr) * 64 + k) * 128 + n]; }
            else { if (k >= 64) v = wg[((size_t)(e * 8 + 2 * pr + 1) * 64 + (k - 64)) * 128 + (n - 128)]; }
            wgx[idx] = f2bf(v);
        }
        float* sacc = (float*)(P.ws + OFF_SACC);
        for (int idx = blockIdx.x * NT + TIDX; idx < 256 * 1024; idx += gridDim.x * NT) sacc[idx] = 0.f;
    }
    {
        float* rc = (float*)(P.ws + OFF_ROPE); float* rs = rc + 32768;
        for (int idx = blockIdx.x * NT + TIDX; idx < 32768; idx += gridDim.x * NT) {
            const int pos = idx >> 3, i = idx & 7;
            const float inv = powf(500000.0f, -0.125f * (float)i);
            const float ang = (float)pos * inv;
            const double x = (double)ang;
            const double k = rint(x * 0.15915494309189535);
            const float rr = (float)(x - k * 6.283185307179586);
            rc[idx] = __cosf(rr); rs[idx] = __sinf(rr);
        }
    }
}

DI void phase_norm(const Params& P, int mode, float scale, const float* __restrict__ g_post, const float* __restrict__ g_next) {
    const int lane = TIDX & 63, wave = TIDX >> 6;
    float* X = P.out + O_Y;
    bf16_t* HN = (bf16_t*)(P.ws + OFF_HN);
    const bf16_t* OUT = (const bf16_t*)(P.ws + OFF_OUT);
    for (int row = blockIdx.x * NW + wave; row < MT; row += gridDim.x * NW) {
        f32x4 xv[4];
        if (mode == 0) {
            const float* src = row < MP ? P.in[I_XP] + (size_t)row * DM : P.in[I_XS] + (size_t)(row - MP) * DM;
#pragma unroll
            for (int i = 0; i < 4; ++i) xv[i] = *(const f32x4*)(src + lane * 4 + 256 * i);
        } else {
            f32x4 ov[4], xo[4]; float ss = 0.f;
#pragma unroll
            for (int i = 0; i < 4; ++i) xo[i] = *(const f32x4*)(X + (size_t)row * DM + lane * 4 + 256 * i);
#pragma unroll
            for (int i = 0; i < 4; ++i) {
                if (row < MP) {
                    const u32x2 w = *(const u32x2*)(OUT + (size_t)row * DM + lane * 4 + 256 * i);
                    ov[i] = (f32x4){__uint_as_float(w.x << 16), __uint_as_float(w.x & 0xffff0000u), __uint_as_float(w.y << 16), __uint_as_float(w.y & 0xffff0000u)};
                } else {
                    float* sp = (float*)(P.ws + OFF_SACC) + (size_t)(row - MP) * DM + lane * 4 + 256 * i;
                    ov[i] = *(const f32x4*)sp;
                    *(f32x4*)sp = (f32x4){0.f, 0.f, 0.f, 0.f};
                }
                ss += ov[i].x * ov[i].x + ov[i].y * ov[i].y + ov[i].z * ov[i].z + ov[i].w * ov[i].w;
            }
            ss = wave_sum(ss);
            const float rstd = rsqrtf(ss * (1.0f / 1024.0f) + EPSN) * scale;
#pragma unroll
            for (int i = 0; i < 4; ++i) {
                const f32x4 gp = *(const f32x4*)(g_post + lane * 4 + 256 * i);
                xv[i] = xo[i] + ov[i] * rstd * gp;
            }
        }
#pragma unroll
        for (int i = 0; i < 4; ++i) *(f32x4*)(X + (size_t)row * DM + lane * 4 + 256 * i) = xv[i];
        if (g_next) {
            float ss = 0.f;
#pragma unroll
            for (int i = 0; i < 4; ++i) ss += xv[i].x * xv[i].x + xv[i].y * xv[i].y + xv[i].z * xv[i].z + xv[i].w * xv[i].w;
            ss = wave_sum(ss);
            const float rstd = rsqrtf(ss * (1.0f / 1024.0f) + EPSN);
#pragma unroll
            for (int i = 0; i < 4; ++i) {
                const f32x4 gn = *(const f32x4*)(g_next + lane * 4 + 256 * i);
                const f32x4 hv = xv[i] * rstd * gn;
                *(u32x2*)(HN + (size_t)row * DM + lane * 4 + 256 * i) = (u32x2){pk2(hv.x, hv.y), pk2(hv.z, hv.w)};
            }
        }
    }
}

DI void cache_prep(const float* __restrict__ ck, const float* __restrict__ cv, bf16_t* __restrict__ KS, bf16_t* __restrict__ VS_, int W) {
    const int cpr = W / 8;
    const int nch = 16 * 1024 * cpr;
    const int gsz = gridDim.x * NT;
    for (int idx0 = blockIdx.x * NT + TIDX; idx0 < 2 * nch; idx0 += 4 * gsz) {
        f32x4 a[4], bb[4]; bf16_t* d[4]; bool ok[4];
#pragma unroll
        for (int u = 0; u < 4; ++u) {
            const int idx = idx0 + u * gsz; ok[u] = idx < 2 * nch;
            const int idc = ok[u] ? idx : idx0;
            const int which = idc >= nch; const int id = which ? idc - nch : idc;
            const int c = id % cpr, rowg = id / cpr, b = rowg >> 10, k = rowg & 1023;
            const float* sp = (which ? cv : ck) + (size_t)rowg * W + c * 8;
            a[u] = *(const f32x4*)sp; bb[u] = *(const f32x4*)(sp + 4);
            d[u] = (which ? VS_ : KS) + ((size_t)(b * KVS + k)) * W + c * 8;
        }
#pragma unroll
        for (int u = 0; u < 4; ++u)
            if (ok[u]) *(u32x4*)d[u] = (u32x4){pk2(a[u].x, a[u].y), pk2(a[u].z, a[u].w), pk2(bb[u].x, bb[u].y), pk2(bb[u].z, bb[u].w)};
    }
    const int nz = 16 * 48 * cpr;
    for (int idx = blockIdx.x * NT + TIDX; idx < 2 * nz; idx += gridDim.x * NT) {
        const int which = idx >= nz; const int id = which ? idx - nz : idx;
        const int c = id % cpr, rowg = id / cpr, b = rowg / 48, k = 1040 + rowg % 48;
        bf16_t* d = (which ? VS_ : KS) + ((size_t)(b * KVS + k)) * W + c * 8;
        *(u32x4*)d = (u32x4){0u, 0u, 0u, 0u};
    }
}

struct GemmArgs { const bf16_t* A; int lda; int a_pn_stride; const bf16_t* Bt; int K; int nM, nN; int nsk, skc; };
enum { EPI_PLAIN = 0, EPI_SWIGLU, EPI_EVEN_IN, EPI_GATES, EPI_ODD_IN, EPI_SACC };

DI bool gemm_next(int it, int nM, int nN, int& pm, int& pn) {
    const int G = gridDim.x;
    if ((G & 7) == 0) {
        const int x = blockIdx.x & 7, bl = blockIdx.x >> 3, bpx = G >> 3, j = bl + it * bpx;
        const int nMx = (nM - x + 7) >> 3;
        if (j >= nMx * nN) return false;
        const int grp = j / (8 * nN), within = j % (8 * nN);
        int gsz = nMx - grp * 8; if (gsz > 8) gsz = 8;
        pn = within / gsz; pm = x + 8 * (grp * 8 + within % gsz);
        return true;
    } else {
        const int t = blockIdx.x + it * G;
        if (t >= nM * nN) return false;
        pm = t / nN; pn = t % nN; return true;
    }
}

template <int EPI>
DI void gemm_epilogue(const Params& P, int li, const f32x16 (&acc)[4][2], int pm, int pn, bf16_t* __restrict__ C, int ldc) {
    const int tid = TIDX, lane = tid & 63, wave = tid >> 6, wr = wave >> 2, wc = wave & 3, r = lane & 31, hh = lane >> 5;
    const int m0 = pm * 256 + wr * 128;
    const bool samp = pm * 256 >= MP;
    if (EPI == EPI_PLAIN) {
#pragma unroll
        for (int mt = 0; mt < 4; ++mt)
#pragma unroll
            for (int i = 0; i < 16; ++i) {
                const int row = m0 + mt * 32 + crow(i, hh);
#pragma unroll
                for (int nt = 0; nt < 2; ++nt) C[(size_t)row * ldc + pn * 256 + wc * 64 + nt * 32 + r] = f2bf(acc[mt][nt][i]);
            }
    } else if (EPI == EPI_SACC) {
        float* S = (float*)(P.ws + OFF_SACC);
#pragma unroll
        for (int mt = 0; mt < 4; ++mt)
#pragma unroll
            for (int i = 0; i < 16; ++i) {
                const int row = wr * 128 + mt * 32 + crow(i, hh);
#pragma unroll
                for (int nt = 0; nt < 2; ++nt) atomicAdd(S + (size_t)row * DM + pn * 256 + wc * 64 + nt * 32 + r, acc[mt][nt][i]);
            }
    } else if (EPI == EPI_SWIGLU) {
        const int j = pn * 128 + wc * 32 + r;
#pragma unroll
        for (int mt = 0; mt < 4; ++mt)
#pragma unroll
            for (int i = 0; i < 16; ++i) {
                const int row = m0 + mt * 32 + crow(i, hh);
                const float g = acc[mt][0][i], u = acc[mt][1][i];
                C[(size_t)row * DFF + j] = f2bf(g / (1.0f + __expf(-g)) * u);
            }
    } else if (EPI == EPI_EVEN_IN) {
        const int e = li;
        const int sec = (pn * 256) >> 9;
        const int cb0 = ((pn * 256) & 511) + wc * 64 + r;
        if (sec == 0) {
            float* U = (float*)(P.ws + R_U);
#pragma unroll
            for (int mt = 0; mt < 4; ++mt)
#pragma unroll
                for (int i = 0; i < 16; ++i) {
                    const int row = m0 + mt * 32 + crow(i, hh);
#pragma unroll
                    for (int nt = 0; nt < 2; ++nt) U[(size_t)row * 512 + cb0 + nt * 32] = acc[mt][nt][i];
                }
        } else if (sec == 1) {
            bf16_t* Gb = (bf16_t*)(P.ws + R_G);
#pragma unroll
            for (int mt = 0; mt < 4; ++mt)
#pragma unroll
                for (int i = 0; i < 16; ++i) {
                    const int row = m0 + mt * 32 + crow(i, hh);
#pragma unroll
                    for (int nt = 0; nt < 2; ++nt) Gb[(size_t)row * 512 + cb0 + nt * 32] = f2bf(gelu_tanh(acc[mt][nt][i]));
                }
        } else if (sec == 2) {
            bf16_t* QE = (bf16_t*)(P.ws + R_QE);
#pragma unroll
            for (int mt = 0; mt < 4; ++mt)
#pragma unroll
                for (int i = 0; i < 16; ++i) {
                    const int row = m0 + mt * 32 + crow(i, hh);
#pragma unroll
                    for (int nt = 0; nt < 2; ++nt) QE[(size_t)row * 512 + cb0 + nt * 32] = f2bf(acc[mt][nt][i] * (0.125f * LOG2E));
                }
        } else if (sec == 3 || sec == 4) {
            bf16_t* bb; float* ob;
            if (!samp) { bb = (bf16_t*)(P.ws + (sec == 3 ? R_KE : R_VE)); ob = P.out + (sec == 3 ? O_PFK : O_PFV) + (size_t)e * (8 * 4096 * 512); }
            else { bb = (bf16_t*)(P.ws + (sec == 3 ? OFF_KS : OFF_VS)); ob = P.out + (sec == 3 ? O_SFK : O_SFV) + (size_t)e * (16 * 16 * 512); }
#pragma unroll
            for (int mt = 0; mt < 4; ++mt)
#pragma unroll
                for (int i = 0; i < 16; ++i) {
                    const int row = m0 + mt * 32 + crow(i, hh);
                    const int mm = row - MP;
                    const size_t rb = samp ? (size_t)((mm >> 4) * KVS + 1024 + (mm & 15)) : (size_t)row;
                    const size_t ro = samp ? (size_t)mm : (size_t)row;
#pragma unroll
                    for (int nt = 0; nt < 2; ++nt) {
                        const float v = acc[mt][nt][i];
                        bb[rb * 512 + cb0 + nt * 32] = f2bf(v);
                        ob[ro * 512 + cb0 + nt * 32] = v;
                    }
                }
        } else {
            float* LF = (float*)(P.ws + R_LOGF);
            if (cb0 < 8) {
                const float bf_ = P.in[I_BFF][e * 8 + cb0];
#pragma unroll
                for (int mt = 0; mt < 4; ++mt)
#pragma unroll
                    for (int i = 0; i < 16; ++i) {
                        const int row = m0 + mt * 32 + crow(i, hh);
                        const int mm = row - MP;
                        const float lf = -softplusf_(-(acc[mt][0][i] + bf_));
                        LF[(size_t)row * 8 + cb0] = lf;
                        if (!samp) P.out[O_PFL + (size_t)e * (8 * 4096 * 8) + (size_t)row * 8 + cb0] = lf;
                        else P.out[O_SFL + (size_t)e * (16 * 16 * 8) + (size_t)mm * 8 + cb0] = lf;
                    }
            }
        }
    } else if (EPI == EPI_GATES) {
        const int e = li, blk = 2 * pn + (wc >> 1);
        float* LA = (float*)(P.ws + R_LA); float* IU = (float*)(P.ws + R_IU); const bf16_t* UC = (const bf16_t*)(P.ws + R_UC);
#pragma unroll
        for (int nt = 0; nt < 2; ++nt) {
            const int n = (wc & 1) * 64 + nt * 32 + r, ch = blk * 64 + (n & 63);
            const float bias = P.in[I_BG][(e * 8 + blk) * 128 + n];
            const float sp = softplusf_(-P.in[I_LAM][e * 512 + ch]);
#pragma unroll
            for (int mt = 0; mt < 4; ++mt)
#pragma unroll
                for (int i = 0; i < 16; ++i) {
                    const int row = m0 + mt * 32 + crow(i, hh);
                    const float sg = sigmoidf_(acc[mt][nt][i] + bias);
                    if ((wc & 1) == 0) LA[(size_t)row * 512 + ch] = -8.0f * sg * sp;
                    else IU[(size_t)row * 512 + ch] = sg * bf2f(UC[(size_t)row * 512 + ch]);
                }
        }
    } else if (EPI == EPI_ODD_IN) {
        const int o = li;
        const int sec = (pn * 256) >> 10;
        bf16_t* QO = (bf16_t*)(P.ws + R_QO); bf16_t* KO = (bf16_t*)(P.ws + R_KO); bf16_t* VO = (bf16_t*)(P.ws + R_VO);
        bf16_t* KSb = (bf16_t*)(P.ws + OFF_KS); bf16_t* VSb = (bf16_t*)(P.ws + OFF_VS);
        const float* rc = (const float*)(P.ws + OFF_ROPE); const float* rs = rc + 32768;
#pragma unroll
        for (int mt = 0; mt < 4; ++mt)
#pragma unroll
            for (int i = 0; i < 16; ++i) {
                const int row = m0 + mt * 32 + crow(i, hh);
                const int mm = row - MP;
                const int pos = samp ? 1024 + (mm & 15) : (row & 4095);
#pragma unroll
                for (int nt = 0; nt < 2; ++nt) {
                    const int c = ((pn * 256) & 1023) + wc * 64 + nt * 32 + r;
                    float v = acc[mt][nt][i];
                    if (sec < 2 && nt == 0) {
                        const float other = __shfl_xor(v, 8);
                        const float cs = rc[pos * 8 + (r & 7)], sn = rs[pos * 8 + (r & 7)];
                        if (r < 8) v = v * cs - other * sn;
                        else if (r < 16) v = v * cs + other * sn;
                    }
                    if (sec == 0) QO[(size_t)row * 1024 + c] = f2bf(v * (0.125f * LOG2E));
                    else {
                        bf16_t* dstb; float* dsto;
                        if (!samp) {
                            dstb = (sec == 1 ? KO : VO) + (size_t)row * 1024 + c;
                            dsto = P.out + (sec == 1 ? O_PDK : O_PDV) + (size_t)o * (8 * 4096 * 1024) + (size_t)row * 1024 + c;
                        } else {
                            dstb = (sec == 1 ? KSb : VSb) + ((size_t)((mm >> 4) * KVS + 1024 + (mm & 15))) * 1024 + c;
                            dsto = P.out + (sec == 1 ? O_SDK : O_SDV) + (size_t)o * (16 * 16 * 1024) + (size_t)mm * 1024 + c;
                        }
                        *dstb = f2bf(v); *dsto = v;
                    }
                }
            }
    }
}

template <bool QUARTER>
DI void gemm_tile_loop(const bf16_t* __restrict__ Ap, int lda, const bf16_t* __restrict__ Bp, int ldb, int ks0, int nks, f32x16 (&acc)[4][2], int q = 0) {
    const int tid = TIDX, lane = tid & 63, wave = tid >> 6, wr = wave >> 2, wc = wave & 3, r = lane & 31, hh = lane >> 5;
    const int sc = tid & 7, sr = tid >> 3;
    LDS char* sm = (LDS char*)smem;
#pragma unroll
    for (int a = 0; a < 4; ++a)
#pragma unroll
        for (int b = 0; b < 2; ++b)
#pragma unroll
            for (int i = 0; i < 16; ++i) acc[a][b][i] = 0.f;
    const unsigned aoff = (unsigned)(sr * lda + sc * 8) * 2u, astep = (unsigned)(64 * lda) * 2u;
    const unsigned boff = (unsigned)(sr * ldb + sc * 8) * 2u, bstep = (unsigned)(64 * ldb) * 2u;
    const int soff = sr * 128 + ((sc ^ ((sr >> 1) & 7)) << 4);
    const char* ap = (const char*)Ap + (size_t)ks0 * 128;
    const char* bp = (const char*)Bp + (size_t)ks0 * 128;
    u32x4 r0a[4], r0b[4], r1a[4], r1b[4];
    auto gload = [&](u32x4 (&ra)[4], u32x4 (&rb)[4], int st) {
        const char* a = ap + (size_t)st * 128; const char* b = bp + (size_t)st * 128;
#pragma unroll
        for (int i = 0; i < 4; ++i) { ra[i] = *(const u32x4*)(a + aoff + i * astep); rb[i] = *(const u32x4*)(b + boff + i * bstep); }
    };
    auto swrite = [&](const u32x4 (&ra)[4], const u32x4 (&rb)[4], int buf) {
#pragma unroll
        for (int i = 0; i < 4; ++i) { *(LDS u32x4*)(sm + buf * 65536 + soff + i * 8192) = ra[i]; *(LDS u32x4*)(sm + buf * 65536 + 32768 + soff + i * 8192) = rb[i]; }
    };
    const int arow = QUARTER ? (wave * 32 + r) * 128 : (wr * 128 + r) * 128, brow = 32768 + ((QUARTER ? q : wc) * 64 + r) * 128, swz = (r >> 1) & 7;
    auto compute = [&](int buf) {
#pragma unroll
        for (int ks = 0; ks < 4; ++ks) {
            const int ch = (((ks << 1) | hh) ^ swz) << 4;
            bf16x8 af[4], bfr[2];
#pragma unroll
            for (int t = 0; t < (QUARTER ? 1 : 4); ++t) af[t] = *(LDS bf16x8*)(sm + buf * 65536 + arow + t * 4096 + ch);
#pragma unroll
            for (int t = 0; t < 2; ++t) bfr[t] = *(LDS bf16x8*)(sm + buf * 65536 + brow + t * 4096 + ch);
#pragma unroll
            for (int mt = 0; mt < (QUARTER ? 1 : 4); ++mt)
#pragma unroll
                for (int nt = 0; nt < 2; ++nt) acc[mt][nt] = MFMA(af[mt], bfr[nt], acc[mt][nt]);
        }
    };
    gload(r0a, r0b, 0);
    if (nks > 1) gload(r1a, r1b, 1);
    swrite(r0a, r0b, 0);
    __syncthreads();
    if (nks > 2) gload(r0a, r0b, 2);
    for (int kt = 0; kt < nks; kt += 2) {
        compute(0);
        if (kt + 1 < nks) swrite(r1a, r1b, 1);
        __syncthreads();
        if (kt + 3 < nks) gload(r1a, r1b, kt + 3);
        if (kt + 1 < nks) {
            compute(1);
            if (kt + 2 < nks) swrite(r0a, r0b, 0);
            __syncthreads();
            if (kt + 4 < nks) gload(r0a, r0b, kt + 4);
        }
    }
}

template <int EPI>
DI void gemm_phase(const Params& P, int li, const GemmArgs g, bf16_t* __restrict__ C, int ldc) {
    int pm, pn, it = 0;
    for (; gemm_next(it, g.nM, g.nN, pm, pn); ++it) {
        const bf16_t* Ap = g.A + (size_t)(pm * 256) * g.lda + (size_t)pn * g.a_pn_stride;
        const bf16_t* Bp = g.Bt + (size_t)(pn * 256) * g.K;
        f32x16 acc[4][2];
        gemm_tile_loop<false>(Ap, g.lda, Bp, g.K, 0, g.K >> 6, acc);
        gemm_epilogue<EPI>(P, li, acc, pm, pn, C, ldc);
        if (EPI == EPI_GATES) {
            __syncthreads();
            const float* LA = (const float*)(P.ws + R_LA); const float* IU = (const float*)(P.ws + R_IU);
            float* SA = (float*)(P.ws + R_SEGA); float* SB = (float*)(P.ws + R_SEGB);
            const bool smp = pm == 128;
            const int nit = (smp ? 16 : 4) * 128, len = smp ? 16 : 64;
            for (int item = TIDX; item < nit; item += NT) {
                const int sl = item >> 7, ch = pn * 128 + (item & 127);
                const int seg = smp ? 512 + sl : pm * 4 + sl, row0 = smp ? MP + sl * 16 : pm * 256 + sl * 64;
                float h = 0.f, p = 1.f;
                for (int j0 = 0; j0 < len; j0 += 8) {
                    float la[8], iu[8];
#pragma unroll
                    for (int j = 0; j < 8; ++j) { la[j] = LA[(size_t)(row0 + j0 + j) * 512 + ch]; iu[j] = IU[(size_t)(row0 + j0 + j) * 512 + ch]; }
#pragma unroll
                    for (int j = 0; j < 8; ++j) {
                        const float a = __expf(la[j]), bx = sqrtf(-expm1f(2.0f * la[j])) * iu[j];
                        h = a * h + bx; p *= a;
                    }
                }
                SA[seg * 512 + ch] = p; SB[seg * 512 + ch] = h;
            }
        }
    }
    if (EPI == EPI_SWIGLU) {
        const int tid = TIDX, lane = tid & 63, wave = tid >> 6, r = lane & 31, hh = lane >> 5;
        for (int j = (int)gridDim.x - 1 - (int)blockIdx.x; j < g.nsk; j += gridDim.x) {
            const int pn2 = j >> 2, q = j & 3;
            const bf16_t* Ap = g.A + (size_t)MP * g.lda;
            const bf16_t* Bp = g.Bt + (size_t)(pn2 * 256) * g.K;
            f32x16 acc[4][2];
            gemm_tile_loop<true>(Ap, g.lda, Bp, g.K, 0, g.K >> 6, acc, q);
            const int jc = pn2 * 128 + q * 32 + r;
#pragma unroll
            for (int i = 0; i < 16; ++i) {
                const int row = MP + wave * 32 + crow(i, hh);
                const float gv = acc[0][0][i], uv = acc[0][1][i];
                C[(size_t)row * DFF + jc] = f2bf(gv / (1.0f + __expf(-gv)) * uv);
            }
        }
    }
    if (EPI == EPI_PLAIN) {
        for (int j = (int)gridDim.x - 1 - (int)blockIdx.x; j < g.nsk; j += gridDim.x) {
            const int pn2 = j % g.nN, kc = j / g.nN;
            const bf16_t* Ap = g.A + (size_t)MP * g.lda;
            const bf16_t* Bp = g.Bt + (size_t)(pn2 * 256) * g.K;
            f32x16 acc[4][2];
            gemm_tile_loop<false>(Ap, g.lda, Bp, g.K, kc * g.skc, g.skc, acc);
            gemm_epilogue<EPI_SACC>(P, li, acc, 128, pn2, nullptr, 0);
        }
    }
}

DI void phase_conv(const Params& P, int e) {
    const float* __restrict__ U = (const float*)(P.ws + R_U);
    bf16_t* __restrict__ UC = (bf16_t*)(P.ws + R_UC);
    const float* cw = P.in[I_CW] + e * 4 * 512; const float* cbias = P.in[I_CB] + e * 512;
    const float* sbuf = P.in[I_SLC] + (size_t)e * 16 * 3 * 512;
    const int gtid = blockIdx.x * NT + TIDX, gsz = gridDim.x * NT;
    for (int idx = gtid; idx < MT * 128; idx += gsz) {
        const int row = idx >> 7, c = (idx & 127) * 4;
        int t, b; const bool samp = row >= MP;
        if (!samp) { t = row & 4095; b = row >> 12; } else { t = (row - MP) & 15; b = (row - MP) >> 4; }
        f32x4 acc = *(const f32x4*)(cbias + c);
#pragma unroll
        for (int j = 0; j < 4; ++j) {
            const int tt = t - 3 + j;
            f32x4 uv;
            if (tt >= 0) uv = *(const f32x4*)(U + (size_t)(row - 3 + j) * 512 + c);
            else if (samp) uv = *(const f32x4*)(sbuf + ((size_t)b * 3 + (3 + tt)) * 512 + c);
            else uv = (f32x4){0.f, 0.f, 0.f, 0.f};
            acc += uv * *(const f32x4*)(cw + j * 512 + c);
        }
        *(u32x2*)(UC + (size_t)row * 512 + c) = (u32x2){pk2(acc.x, acc.y), pk2(acc.z, acc.w)};
    }
    for (int idx = gtid; idx < (8 + 16) * 3 * 512; idx += gsz) {
        const int c = idx & 511, i = (idx >> 9) % 3, s = idx / 1536;
        if (s < 8) P.out[O_PLC + ((size_t)(e * 8 + s) * 3 + i) * 512 + c] = U[(size_t)(s * 4096 + 4093 + i) * 512 + c];
        else P.out[O_SLC + ((size_t)(e * 16 + (s - 8)) * 3 + i) * 512 + c] = U[(size_t)(MP + (s - 8) * 16 + 13 + i) * 512 + c];
    }
    const float* LF = (const float*)(P.ws + R_LOGF);
    float* CBP = (float*)(P.ws + R_CBP); float* CBS = (float*)(P.ws + R_CBS);
    const int lane = TIDX & 63;
    for (int w = blockIdx.x * NW + (TIDX >> 6); w < 64 + 128; w += gridDim.x * NW) {
        if (w < 64) {
            const int s = w >> 3, h = w & 7;
            float loc = 0.f;
            for (int j0 = 0; j0 < 64; j0 += 16) {
                float v[16];
#pragma unroll
                for (int j = 0; j < 16; ++j) v[j] = LF[(size_t)(s * 4096 + lane * 64 + j0 + j) * 8 + h];
#pragma unroll
                for (int j = 0; j < 16; ++j) loc += v[j];
            }
            float inc = loc;
#pragma unroll
            for (int o = 1; o < 64; o <<= 1) { const float t = __shfl_up(inc, o); if (lane >= o) inc += t; }
            float run = inc - loc;
            for (int j0 = 0; j0 < 64; j0 += 16) {
                float v[16];
#pragma unroll
                for (int j = 0; j < 16; ++j) v[j] = LF[(size_t)(s * 4096 + lane * 64 + j0 + j) * 8 + h];
#pragma unroll
                for (int j = 0; j < 16; ++j) { run += v[j]; v[j] = -run * LOG2E; }
#pragma unroll
                for (int j = 0; j < 16; ++j) CBP[(size_t)(s * 8 + h) * 4096 + lane * 64 + j0 + j] = v[j];
            }
        } else {
            const int b = (w - 64) >> 3, h = (w - 64) & 7;
            const float* cl = P.in[I_CFL] + (size_t)(e * 16 + b) * 1024 * 8;
            float loc = 0.f;
            for (int j = 0; j < 17; ++j) {
                const int k = lane * 17 + j;
                float v = 0.f;
                if (k < 1024) v = cl[(size_t)k * 8 + h]; else if (k < 1040) v = LF[(size_t)(MP + b * 16 + (k - 1024)) * 8 + h];
                loc += v;
            }
            float inc = loc;
#pragma unroll
            for (int o = 1; o < 64; o <<= 1) { const float t = __shfl_up(inc, o); if (lane >= o) inc += t; }
            float run = inc - loc;
            for (int j = 0; j < 17; ++j) {
                const int k = lane * 17 + j;
                float v = 0.f;
                if (k < 1024) v = cl[(size_t)k * 8 + h]; else if (k < 1040) v = LF[(size_t)(MP + b * 16 + (k - 1024)) * 8 + h];
                run += v;
                CBS[(size_t)(b * 8 + h) * KVS + k] = -run * LOG2E;
            }
        }
    }
}

DI void seg_info(int seg, int& row0, int& len) { if (seg < 512) { row0 = seg * 64; len = 64; } else { row0 = MP + (seg - 512) * 16; len = 16; } }

DI void phase_scan1(const Params& P) {
    const float* LA = (const float*)(P.ws + R_LA); const float* IU = (const float*)(P.ws + R_IU);
    float* SA = (float*)(P.ws + R_SEGA); float* SB = (float*)(P.ws + R_SEGB);
    for (int idx = blockIdx.x * NT + TIDX; idx < 528 * 512; idx += gridDim.x * NT) {
        const int seg = idx >> 9, c = idx & 511;
        int row0, len; seg_info(seg, row0, len);
        float h = 0.f, p = 1.f;
        for (int j0 = 0; j0 < len; j0 += 8) {
            float la[8], iu[8];
#pragma unroll
            for (int j = 0; j < 8; ++j) { la[j] = LA[(size_t)(row0 + j0 + j) * 512 + c]; iu[j] = IU[(size_t)(row0 + j0 + j) * 512 + c]; }
#pragma unroll
            for (int j = 0; j < 8; ++j) {
                const float a = __expf(la[j]), bx = sqrtf(-expm1f(2.0f * la[j])) * iu[j];
                h = a * h + bx; p *= a;
            }
        }
        SA[idx] = p; SB[idx] = h;
    }
}

DI void phase_scan3(const Params& P, int e) {
    const float* LA = (const float*)(P.ws + R_LA); const float* IU = (const float*)(P.ws + R_IU);
    const float* SA = (const float*)(P.ws + R_SEGA); const float* SB = (const float*)(P.ws + R_SEGB);
    const bf16_t* Gb = (const bf16_t*)(P.ws + R_G);
    bf16_t* MIX = (bf16_t*)(P.ws + OFF_HN);
    for (int idx = blockIdx.x * NT + TIDX; idx < 528 * 512; idx += gridDim.x * NT) {
        const int seg = idx >> 9, c = idx & 511;
        int row0, len; seg_info(seg, row0, len);
        float h = 0.f;
        if (seg < 512) {
            const int s0 = seg & ~63;
            for (int sb = s0; sb < seg; sb += 8) {
                float sa[8], sbv[8];
#pragma unroll
                for (int j = 0; j < 8; ++j) { const int sj = (sb + j < seg) ? sb + j : s0; sa[j] = SA[sj * 512 + c]; sbv[j] = SB[sj * 512 + c]; }
#pragma unroll
                for (int j = 0; j < 8; ++j) if (sb + j < seg) h = sa[j] * h + sbv[j];
            }
        }
        else h = P.in[I_SLH][(size_t)(e * 16 + (seg - 512)) * 512 + c];
        for (int j0 = 0; j0 < len; j0 += 8) {
            float la[8], iu[8], gg[8], y[8];
#pragma unroll
            for (int j = 0; j < 8; ++j) {
                la[j] = LA[(size_t)(row0 + j0 + j) * 512 + c]; iu[j] = IU[(size_t)(row0 + j0 + j) * 512 + c];
                gg[j] = bf2f(Gb[(size_t)(row0 + j0 + j) * 512 + c]);
            }
#pragma unroll
            for (int j = 0; j < 8; ++j) {
                const float a = __expf(la[j]), bx = sqrtf(-expm1f(2.0f * la[j])) * iu[j];
                h = a * h + bx; y[j] = h * gg[j];
            }
#pragma unroll
            for (int j = 0; j < 8; ++j) MIX[(size_t)(row0 + j0 + j) * 1024 + c] = f2bf(y[j]);
        }
        if (seg < 512) { if ((seg & 63) == 63) P.out[O_PLH + (size_t)(e * 8 + (seg >> 6)) * 512 + c] = h; }
        else P.out[O_SLH + (size_t)(e * 16 + (seg - 512)) * 512 + c] = h;
    }
}

template <int DV, bool BIAS>
DI void flash_pass(const bf16_t* __restrict__ Qb, int ldq, const bf16_t* __restrict__ Kb, int ldk, const bf16_t* __restrict__ Vb, int ldv,
                   const float* __restrict__ cb, int q0, int nq, int past, int mode, int kvlen, f32x16 (&O)[DV / 32], float& l_out) {
    constexpr int VSTR = (DV == 64) ? 192 : 320;
    constexpr int BUFSZ = 8192 + 64 * VSTR + 256;
    constexpr int VCH = DV / 8, NVL = (64 * VCH) / NT;
    const int tid = TIDX, lane = tid & 63, wave = tid >> 6, r = lane & 31, hh = lane >> 5;
    LDS char* sm = (LDS char*)smem;
    const int qw0 = q0 + wave * 32;
    const bool wactive = qw0 < nq;
    int qi = qw0 + r; if (qi > nq - 1) qi = nq - 1;
    const int qabs = past + qi;
    int klim = qabs; if (mode == 1) { klim = qabs | 63; if (klim > kvlen - 1) klim = kvlen - 1; }
    int qlw = qw0 + 31; if (qlw > nq - 1) qlw = nq - 1;
    int wkmax = past + qlw; if (mode == 1) { wkmax |= 63; if (wkmax > kvlen - 1) wkmax = kvlen - 1; }
    const int wkmin = (mode == 0) ? past + qw0 : wkmax;
    int qlb = q0 + NW * 32 - 1; if (qlb > nq - 1) qlb = nq - 1;
    int bkmax = past + qlb; if (mode == 1) { bkmax |= 63; if (bkmax > kvlen - 1) bkmax = kvlen - 1; }
    const int ntiles = (bkmax >> 6) + 1;

    bf16x8 qf[4];
#pragma unroll
    for (int ks = 0; ks < 4; ++ks) qf[ks] = *(const bf16x8*)(Qb + (size_t)qi * ldq + ks * 16 + hh * 8);
#pragma unroll
    for (int dt = 0; dt < DV / 32; ++dt)
#pragma unroll
        for (int i = 0; i < 16; ++i) O[dt][i] = 0.f;
    float m = -1e30f, l = 0.f;

    u32x4 rk[1], rv[NVL]; f32x4 rc4 = {0.f, 0.f, 0.f, 0.f};
    unsigned koff[1], vofs[NVL];
#pragma unroll
    for (int i = 0; i < 1; ++i) { const int idx = tid + NT * i, row = idx >> 3, c = idx & 7; koff[i] = (unsigned)(row * ldk + c * 8) * 2u; }
#pragma unroll
    for (int i = 0; i < NVL; ++i) { const int idx = tid + NT * i, row = idx / VCH, c = idx % VCH; vofs[i] = (unsigned)(row * ldv + c * 8) * 2u; }
    auto prefetch = [&](int kt) {
        const char* kp = (const char*)Kb + (size_t)kt * 128 * ldk;
        const char* vp = (const char*)Vb + (size_t)kt * 128 * ldv;
#pragma unroll
        for (int i = 0; i < 1; ++i) rk[i] = *(const u32x4*)(kp + koff[i]);
        if (DV == 64) {
#pragma unroll
            for (int i = 0; i < NVL; ++i) rv[i] = *(const u32x4*)(vp + vofs[i]);
        }
        if (BIAS) { if (tid < 16) rc4 = *(const f32x4*)(cb + kt * 64 + tid * 4); }
    };
    auto late_v = [&](int kt) {
        if (DV != 64) {
            const char* vp = (const char*)Vb + (size_t)kt * 128 * ldv;
#pragma unroll
            for (int i = 0; i < NVL; ++i) rv[i] = *(const u32x4*)(vp + vofs[i]);
        }
    };
    auto stash = [&](int buf) {
        LDS char* b = sm + buf * BUFSZ;
#pragma unroll
        for (int i = 0; i < 1; ++i) { const int idx = tid + NT * i, row = idx >> 3, c = idx & 7; *(LDS u32x4*)(b + row * 128 + ((c ^ ((row >> 1) & 7)) << 4)) = rk[i]; }
#pragma unroll
        for (int i = 0; i < NVL; ++i) { const int idx = tid + NT * i, row = idx / VCH, c = idx % VCH; *(LDS u32x4*)(b + 8192 + row * VSTR + c * 16) = rv[i]; }
        if (BIAS) { if (tid < 16) *(LDS f32x4*)(b + 8192 + 64 * VSTR + tid * 16) = rc4; }
    };
    prefetch(0); late_v(0); stash(0); __syncthreads();
    const int q4 = (lane & 15) >> 2, p4 = lane & 3, g1 = (lane >> 4) & 1;
    const int voff = (4 * hh + q4) * VSTR + (16 * g1 + 4 * p4) * 2;
    for (int kt = 0; kt < ntiles; ++kt) {
        if (kt + 1 < ntiles) prefetch(kt + 1);
        if (wactive && kt * 64 <= wkmax) {
            LDS char* kb = sm + (kt & 1) * BUFSZ; LDS char* vb = kb + 8192; LDS char* cbp = vb + 64 * VSTR;
            const bool need_mask = kt * 64 + 63 > wkmin;
#pragma unroll
            for (int st = 0; st < 2; ++st) {
                asm volatile("" ::: "memory");
                f32x16 S;
#pragma unroll
                for (int i = 0; i < 16; ++i) S[i] = 0.f;
#pragma unroll
                for (int ks = 0; ks < 4; ++ks) {
                    const bf16x8 a = *(LDS bf16x8*)(kb + (st * 32 + r) * 128 + ((((ks << 1) | hh) ^ ((r >> 1) & 7)) << 4));
                    S = MFMA(a, qf[ks], S);
                }
                if (BIAS) {
#pragma unroll
                    for (int g = 0; g < 4; ++g) {
                        const f32x4 c4 = *(LDS f32x4*)(cbp + (st * 32 + 8 * g + 4 * hh) * 4);
                        S[4 * g + 0] += c4.x; S[4 * g + 1] += c4.y; S[4 * g + 2] += c4.z; S[4 * g + 3] += c4.w;
                    }
                }
                if (need_mask) {
#pragma unroll
                    for (int i = 0; i < 16; ++i) { const int key = kt * 64 + st * 32 + crow(i, hh); if (key > klim) S[i] = -1e30f; }
                }
                float mx = S[0];
#pragma unroll
                for (int i = 1; i < 16; ++i) mx = fmaxf(mx, S[i]);
                mx = fmaxf(mx, __shfl_xor(mx, 32));
                if (__any(mx > m)) {
                    const float mn = fmaxf(m, mx);
                    const float alpha = __builtin_amdgcn_exp2f(m - mn);
                    m = mn; l *= alpha;
#pragma unroll
                    for (int dt = 0; dt < DV / 32; ++dt)
#pragma unroll
                        for (int i = 0; i < 16; ++i) O[dt][i] *= alpha;
                }
                float ps = 0.f;
#pragma unroll
                for (int i = 0; i < 16; ++i) { const float p = __builtin_amdgcn_exp2f(S[i] - m); S[i] = p; ps += p; }
                l += ps;
                bf16x8 pf[2];
#pragma unroll
                for (int s = 0; s < 2; ++s) {
                    const u32x4 w = {pk2(S[8 * s + 0], S[8 * s + 1]), pk2(S[8 * s + 2], S[8 * s + 3]), pk2(S[8 * s + 4], S[8 * s + 5]), pk2(S[8 * s + 6], S[8 * s + 7])};
                    pf[s] = __builtin_bit_cast(bf16x8, w);
                }
#pragma unroll
                for (int dt = 0; dt < DV / 32; ++dt) {
                    if (DV > 64) asm volatile("" ::: "memory");
#pragma unroll
                    for (int s = 0; s < 2; ++s) {
                        const s16x4 lo = __builtin_amdgcn_ds_read_tr16_b64_v4i16((LDS s16x4*)(vb + voff + (st * 32 + s * 16) * VSTR + dt * 64));
                        const s16x4 hi = __builtin_amdgcn_ds_read_tr16_b64_v4i16((LDS s16x4*)(vb + voff + (st * 32 + s * 16 + 8) * VSTR + dt * 64));
                        const bf16x8 a = __builtin_shufflevector(lo, hi, 0, 1, 2, 3, 4, 5, 6, 7);
                        O[dt] = MFMA(a, pf[s], O[dt]);
                    }
                }
            }
        }
        if (kt + 1 < ntiles) { late_v(kt + 1); stash((kt + 1) & 1); }
        __syncthreads();
    }
    l_out = l + __shfl_xor(l, 32);
}

DI int next_unit(unsigned* ctr) {
    LDS int* su = (LDS int*)((LDS char*)smem + 65528);
    if (TIDX == 0) *su = (int)atomicAdd(ctr, 1u);
    __syncthreads();
    const int u = *su;
    __syncthreads();
    return u;
}

DI void unit_decode(int u, int& samp, int& s, int& h, int& qb) {
    if (u < 128) { samp = 1; s = u >> 3; h = u & 7; qb = 0; }
    else { const int v = u - 128; samp = 0; qb = 15 - (v >> 6); s = (v & 63) >> 3; h = v & 7; }
}

DI void phase_fox_attn(const Params& P, unsigned* ctr) {
    const bf16_t* QE = (const bf16_t*)(P.ws + R_QE);
    bf16_t* MIX = (bf16_t*)(P.ws + OFF_HN);
    const int lane = TIDX & 63, wave = TIDX >> 6, r = lane & 31, hh = lane >> 5;
    for (;;) {
        const int u = next_unit(ctr);
        if (u >= 128 + 1024) break;
        int samp, s, h, qb; unit_decode(u, samp, s, h, qb);
        const bf16_t *Qb, *Kb, *Vb; const float* cb; int nq, past, kvlen, row0;
        if (!samp) {
            row0 = s * 4096; nq = 4096; past = 0; kvlen = 4096;
            Kb = (const bf16_t*)(P.ws + R_KE) + (size_t)row0 * 512 + h * 64; Vb = (const bf16_t*)(P.ws + R_VE) + (size_t)row0 * 512 + h * 64;
            cb = (const float*)(P.ws + R_CBP) + (size_t)(s * 8 + h) * 4096;
        } else {
            row0 = MP + s * 16; nq = 16; past = 1024; kvlen = 1040;
            Kb = (const bf16_t*)(P.ws + OFF_KS) + (size_t)s * KVS * 512 + h * 64; Vb = (const bf16_t*)(P.ws + OFF_VS) + (size_t)s * KVS * 512 + h * 64;
            cb = (const float*)(P.ws + R_CBS) + (size_t)(s * 8 + h) * KVS;
        }
        Qb = QE + (size_t)row0 * 512 + h * 64;
        f32x16 O[2]; float l;
        flash_pass<64, true>(Qb, 512, Kb, 512, Vb, 512, cb, qb * 256, nq, past, 0, kvlen, O, l);
        const int qi = qb * 256 + wave * 32 + r;
        if (qi < nq) {
            const float inv = 1.0f / l;
            bf16_t* dst = MIX + (size_t)(row0 + qi) * 1024 + 512 + h * 64;
#pragma unroll
            for (int dt = 0; dt < 2; ++dt)
#pragma unroll
                for (int g = 0; g < 4; ++g)
                    *(u32x2*)(dst + dt * 32 + 8 * g + 4 * hh) = (u32x2){pk2(O[dt][4 * g] * inv, O[dt][4 * g + 1] * inv), pk2(O[dt][4 * g + 2] * inv, O[dt][4 * g + 3] * inv)};
        }
    }
}

DI void phase_diff_attn(const Params& P, int o, int layer, unsigned* ctr) {
    const bf16_t* QO = (const bf16_t*)(P.ws + R_QO);
    float* O1 = (float*)(P.ws + R_O1);
    bf16_t* MIX = (bf16_t*)(P.ws + OFF_HN);
    const int lane = TIDX & 63, wave = TIDX >> 6, r = lane & 31, hh = lane >> 5;
    const float lam_init = 0.8f - 0.6f * expf(-0.3f * (float)layer);
    const float* lp = P.in[I_DLAM] + o * 256;
    const float s1 = wave_sum(lp[lane] * lp[64 + lane]), s2 = wave_sum(lp[128 + lane] * lp[192 + lane]);
    const float lam = expf(s1) - expf(s2) + lam_init;
    const float* sg = P.in[I_SUBG] + o * 128;
    for (;;) {
        const int u = next_unit(ctr);
        if (u >= 128 + 1024) break;
        int samp, s, h, qb; unit_decode(u, samp, s, h, qb);
        const bf16_t *Kb, *Vb; int nq, past, kvlen, row0;
        if (!samp) {
            row0 = s * 4096; nq = 4096; past = 0; kvlen = 4096;
            Kb = (const bf16_t*)(P.ws + R_KO) + (size_t)row0 * 1024 + h * 128; Vb = (const bf16_t*)(P.ws + R_VO) + (size_t)row0 * 1024 + h * 128;
        } else {
            row0 = MP + s * 16; nq = 16; past = 1024; kvlen = 1040;
            Kb = (const bf16_t*)(P.ws + OFF_KS) + (size_t)s * KVS * 1024 + h * 128; Vb = (const bf16_t*)(P.ws + OFF_VS) + (size_t)s * KVS * 1024 + h * 128;
        }
        const bf16_t* Qb = QO + (size_t)row0 * 1024 + h * 128;
        const int qi = qb * 256 + wave * 32 + r;
        const unsigned rowc = (unsigned)(row0 + (qi < nq ? qi : nq - 1));
        const unsigned o1off = (rowc * 1024u + (unsigned)(h * 128 + 4 * hh)) * 4u;
        const unsigned mixoff = (rowc * 1024u + (unsigned)(h * 128 + 4 * hh)) * 2u;
        for (int c = 0; c < 2; ++c) {
            f32x16 O[4]; float l;
            flash_pass<128, false>(Qb + c * 64, 1024, Kb + c * 64, 1024, Vb, 1024, nullptr, qb * 256, nq, past, 1, kvlen, O, l);
            if (qi < nq) {
                const float inv = 1.0f / l;
                char* o1p = (char*)O1 + o1off;
                if (c == 0) {
#pragma unroll
                    for (int dt = 0; dt < 4; ++dt)
#pragma unroll
                        for (int g = 0; g < 4; ++g)
                            *(f32x4*)(o1p + (dt * 32 + 8 * g) * 4) = (f32x4){O[dt][4 * g] * inv, O[dt][4 * g + 1] * inv, O[dt][4 * g + 2] * inv, O[dt][4 * g + 3] * inv};
                } else {
                    float ss = 0.f;
                    const float nl = -lam * inv;
#pragma unroll
                    for (int dt = 0; dt < 4; ++dt)
#pragma unroll
                        for (int i = 0; i < 16; ++i) O[dt][i] *= nl;
#pragma unroll
                    for (int dt = 0; dt < 4; ++dt) {
#pragma unroll
                        for (int g = 0; g < 4; ++g) {
                            const f32x4 a = *(const f32x4*)(o1p + (dt * 32 + 8 * g) * 4);
#pragma unroll
                            for (int j = 0; j < 4; ++j) { const float v = a[j] + O[dt][4 * g + j]; O[dt][4 * g + j] = v; ss += v * v; }
                        }
                        asm volatile("" : "+v"(ss) :: "memory");
                    }
                    ss += __shfl_xor(ss, 32);
                    const float rstd = rsqrtf(ss * (1.0f / 128.0f) + EPSN) * (1.0f - lam_init);
                    char* dst = (char*)MIX + mixoff;
                    const char* sgp = (const char*)sg + hh * 16;
#pragma unroll
                    for (int dt = 0; dt < 4; ++dt) {
                        asm volatile("" ::: "memory");
#pragma unroll
                        for (int g = 0; g < 4; ++g) {
                            const f32x4 gg = *(const f32x4*)(sgp + (dt * 32 + 8 * g) * 4);
                            *(u32x2*)(dst + (dt * 32 + 8 * g) * 2) = (u32x2){pk2(O[dt][4 * g] * rstd * gg.x, O[dt][4 * g + 1] * rstd * gg.y), pk2(O[dt][4 * g + 2] * rstd * gg.z, O[dt][4 * g + 3] * rstd * gg.w)};
                        }
                        asm volatile("" ::: "memory");
                    }
                }
            }
        }
    }
}


#define XB_TMO      128
#define XB_XCNT(j)  (256  + 64 * (j))
#define XB_XSUB(j)  (1280 + 64 * (j))
#define XB_XGEN(j)  (2304 + 64 * (j))
#define XB_TOP      3328
#define XB_TOPGEN   3392
#define XCD_BAR_WORDS 3456
#define XB_SPIN_CAP (1u << 22)
DI unsigned xb_ld(unsigned* p) { return __hip_atomic_load(p, __ATOMIC_RELAXED, __HIP_MEMORY_SCOPE_AGENT); }
DI unsigned xb_add(unsigned* p, unsigned v) { return __hip_atomic_fetch_add(p, v, __ATOMIC_RELAXED, __HIP_MEMORY_SCOPE_AGENT); }
DI unsigned xb_xcc_id() { return (unsigned)__builtin_amdgcn_s_getreg((3 << 11) | 20) & 0xFu; }
#define XB_SPIN(cond, bar) do { unsigned _sp = 0; while (cond) { __builtin_amdgcn_s_sleep(1); \
    if ((++_sp & 255u) == 0u) { if (xb_ld(&(bar)[XB_TMO])) break; if (_sp > XB_SPIN_CAP) { atomicAdd(&(bar)[XB_TMO], 1u); break; } } } } while (0)
__shared__ __attribute__((aligned(16))) unsigned xb_words[4];
struct XcdBarrier { unsigned* bar; unsigned x; };
DI XcdBarrier xcd_barrier_post(unsigned* bar) {
    XcdBarrier b; b.bar = bar; b.x = xb_xcc_id();
    if (threadIdx.x == 0) (void)xb_add(&bar[XB_XCNT(b.x)], 1u);
    return b;
}
DI void xcd_barrier_complete(unsigned* bar, unsigned x, unsigned& nloc, unsigned& nx) {
    const unsigned G = gridDim.x * gridDim.y * gridDim.z;
    unsigned sum, cnt, mine, sp = 0u;
    for (;;) {
        sum = 0u; cnt = 0u; mine = 0u;
#pragma unroll
        for (unsigned j = 0; j < 16; ++j) { const unsigned c = xb_ld(&bar[XB_XCNT(j)]); sum += c; cnt += (c > 0u) ? 1u : 0u; mine = (j == x) ? c : mine; }
        if (sum == G) break;
        __builtin_amdgcn_s_sleep(1);
        if ((++sp & 255u) == 0u) { if (xb_ld(&bar[XB_TMO])) break; if (sp > XB_SPIN_CAP) { atomicAdd(&bar[XB_TMO], 1u); break; } }
    }
    nloc = mine > 0u ? mine : 1u; nx = cnt > 0u ? cnt : 1u;
}
DI void xcd_barrier(const XcdBarrier& b) {
    volatile LDS unsigned* st = (volatile LDS unsigned*)xb_words;
    asm volatile("s_waitcnt vmcnt(0)" ::: "memory");
    __syncthreads();
    if (threadIdx.x == 0) {
        unsigned* bar = b.bar;
        __builtin_amdgcn_s_waitcnt(0);
        unsigned nloc = st[0], nx = st[1];
        if (nloc == 0u) { xcd_barrier_complete(bar, b.x, nloc, nx); st[0] = nloc; st[1] = nx; }
        const unsigned old = xb_add(&bar[XB_XSUB(b.x)], 1u);
        const unsigned gen = old / nloc;
        if (old + 1u == (gen + 1u) * nloc) {
            __builtin_amdgcn_fence(__ATOMIC_RELEASE, "agent");
            asm volatile("s_waitcnt vmcnt(0)" ::: "memory");
            const unsigned og = xb_add(&bar[XB_TOP], 1u);
            const unsigned tg = og / nx;
            if (og + 1u == (tg + 1u) * nx) xb_add(&bar[XB_TOPGEN], 1u);
            else XB_SPIN(xb_ld(&bar[XB_TOPGEN]) == tg, bar);
            __builtin_amdgcn_fence(__ATOMIC_ACQUIRE, "agent");
            xb_add(&bar[XB_XGEN(b.x)], 1u);
            asm volatile("s_waitcnt vmcnt(0)" ::: "memory");
        } else {
            XB_SPIN(xb_ld(&bar[XB_XGEN(b.x)]) == gen, bar);
            __builtin_amdgcn_fence(__ATOMIC_ACQUIRE, "agent");
            asm volatile("s_waitcnt vmcnt(0)" ::: "memory");
        }
    }
    __syncthreads();
}

constexpr int NPHASE = 45;
DI void run_phase(const Params& P, int ph) {
    unsigned* ctrl = (unsigned*)(P.ws + OFF_CTRL);
    if (ph == 0) {
        phase_prologue(P);
        phase_norm(P, 0, 0.f, nullptr, P.in[I_NG]);
        return;
    }
    int q = ph - 1, l, st;
    if (q < 12) { l = 0; st = q; } else if (q < 22) { l = 1; st = q - 12; } else if (q < 34) { l = 2; st = q - 22; } else { l = 3; st = q - 34; }
    const bool even = (l & 1) == 0; const int li = l >> 1;
    const float* ng = P.in[I_NG] + (size_t)l * 6 * DM;
    const bf16_t* HN = (const bf16_t*)(P.ws + OFF_HN);
    bf16_t* OUT = (bf16_t*)(P.ws + OFF_OUT);
    bf16_t* ACT = (bf16_t*)(P.ws + R_ACT);
    const bf16_t* wfi = (const bf16_t*)(P.ws + OFF_WT_FFN_IN); const bf16_t* wfo = (const bf16_t*)(P.ws + OFF_WT_FFN_OUT);
    const int nst = even ? 12 : 10;
    if (st == 0 || st == nst - 3) {
        const int f = (st == 0) ? 0 : 1;
        GemmArgs g{HN, DM, 0, wfi + (size_t)(l * 2 + f) * 5632 * 1024, 1024, 128, 22, 88, 0};
        gemm_phase<EPI_SWIGLU>(P, 0, g, ACT, DFF);
    } else if (st == 1 || st == nst - 2) {
        const int f = (st == 1) ? 0 : 1;
        GemmArgs g{ACT, DFF, 0, wfo + (size_t)(l * 2 + f) * 1024 * DFF, DFF, 128, 4, 176, 1};
        gemm_phase<EPI_PLAIN>(P, 0, g, OUT, DM);
    } else if (st == 2) {
        phase_norm(P, 1, 0.5f, ng + 1 * DM, ng + 2 * DM);
        if (even) cache_prep(P.in[I_CFK] + (size_t)li * 16 * 1024 * 512, P.in[I_CFV] + (size_t)li * 16 * 1024 * 512, (bf16_t*)(P.ws + OFF_KS), (bf16_t*)(P.ws + OFF_VS), 512);
        else cache_prep(P.in[I_CDK] + (size_t)li * 16 * 1024 * 1024, P.in[I_CDV] + (size_t)li * 16 * 1024 * 1024, (bf16_t*)(P.ws + OFF_KS), (bf16_t*)(P.ws + OFF_VS), 1024);
    } else if (st == nst - 1) {
        phase_norm(P, 1, 0.5f, ng + 5 * DM, (l < 3) ? ng + 6 * DM : nullptr);
    } else if (st == nst - 4) {
        phase_norm(P, 1, 1.0f, ng + 3 * DM, ng + 4 * DM);
    } else if (st == nst - 5) {
        const bf16_t* wo = even ? (const bf16_t*)(P.ws + OFF_WT_OUT_EVEN) : (const bf16_t*)(P.ws + OFF_WT_OUT_ODD);
        GemmArgs g{HN, DM, 0, wo + (size_t)li * 1024 * 1024, 1024, 128, 4, 64, 1};
        gemm_phase<EPI_PLAIN>(P, 0, g, OUT, DM);
    } else if (even) {
        if (st == 3) {
            GemmArgs g{HN, DM, 0, (const bf16_t*)(P.ws + OFF_WT_IN_EVEN) + (size_t)li * 2816 * 1024, 1024, 129, 11, 0, 0};
            gemm_phase<EPI_EVEN_IN>(P, li, g, nullptr, 0);
        } else if (st == 4) {
            phase_conv(P, li);
        } else if (st == 5) {
            GemmArgs g{(const bf16_t*)(P.ws + R_UC), 512, 128, (const bf16_t*)(P.ws + OFF_WT_GATES) + (size_t)li * 4 * 256 * 128, 128, 129, 4, 0, 0};
            gemm_phase<EPI_GATES>(P, li, g, nullptr, 0);
        } else if (st == 6) {
            phase_scan3(P, li);
            phase_fox_attn(P, ctrl + 16 * l);
        }
    } else {
        if (st == 3) {
            GemmArgs g{HN, DM, 0, (const bf16_t*)(P.ws + OFF_WT_IN_ODD) + (size_t)li * 3072 * 1024, 1024, 129, 12, 0, 0};
            gemm_phase<EPI_ODD_IN>(P, li, g, nullptr, 0);
        } else if (st == 4) {
            phase_diff_attn(P, li, l, ctrl + 16 * l);
        }
    }
}

#if MULTI_LAUNCH
__global__ void __launch_bounds__(512, 2) phase_kernel(Params P, int ph) { run_phase(P, ph); }
#else
__global__ void __launch_bounds__(512, 2) mega_kernel(Params P) {
    cg::grid_group grid = cg::this_grid();
    if (threadIdx.x < 4) xb_words[threadIdx.x] = 0u;
    __syncthreads();
    const XcdBarrier xb = xcd_barrier_post((unsigned*)(P.ws + OFF_BAR));
    for (int ph = 0; ph < NPHASE; ++ph) {
        run_phase(P, ph);
        if (ph == 0) grid.sync();
        else if (ph + 1 < NPHASE) xcd_barrier(xb);
    }
}
#endif

extern "C" void kernel_launch(void* const* d_in, const int* in_sizes, int n_in, void* d_out, int out_size, void* d_ws, size_t ws_size,
                              hipStream_t stream) {
    Params p{};
    for (int i = 0; i < 24; ++i) p.in[i] = (const float*)d_in[i];
    p.out = (float*)d_out; p.ws = (char*)d_ws;
    if (ws_size < WS_NEEDED) fprintf(stderr, "workspace too small: %zu < %zu\n", ws_size, (size_t)WS_NEEDED);
    hipMemsetAsync(d_ws, 0, 20480, stream);
    static int grid_blocks = 0;
    if (!grid_blocks) {
        int dev = 0, cus = 0, per_cu = 0;
        hipGetDevice(&dev);
        hipDeviceGetAttribute(&cus, hipDeviceAttributeMultiprocessorCount, dev);
#if MULTI_LAUNCH
        hipOccupancyMaxActiveBlocksPerMultiprocessor(&per_cu, phase_kernel, NT, 0);
#else
        hipOccupancyMaxActiveBlocksPerMultiprocessor(&per_cu, mega_kernel, NT, 0);
#endif
        if (per_cu < 1) per_cu = 1;
        if (per_cu > 1) per_cu = 1;
        grid_blocks = cus * per_cu;
    }
#if MULTI_LAUNCH
    for (int ph = 0; ph < NPHASE; ++ph) phase_kernel<<<grid_blocks, NT, 0, stream>>>(p, ph);
#else
    void* args[] = {&p};
    hipError_t e = hipLaunchCooperativeKernel((void*)mega_kernel, dim3(grid_blocks), dim3(NT), args, 0, stream);
    if (e != hipSuccess) fprintf(stderr, "cooperative launch failed: %s (grid %d)\n", hipGetErrorString(e), grid_blocks);
#endif
}
```

```cpp
#include <hip/hip_runtime.h>
#include <hip/hip_cooperative_groups.h>
#include <cstdio>
#include <cstdint>
namespace cg = cooperative_groups;

#ifndef MULTI_LAUNCH
#define MULTI_LAUNCH 0
#endif

#define DI __device__ __forceinline__
#define LDS __attribute__((address_space(3)))
typedef unsigned short bf16_t;
typedef short bf16x8 __attribute__((ext_vector_type(8)));
typedef short s16x4 __attribute__((ext_vector_type(4)));
typedef float f32x16 __attribute__((ext_vector_type(16)));
typedef float f32x4 __attribute__((ext_vector_type(4)));
typedef float f32x2 __attribute__((ext_vector_type(2)));
typedef unsigned u32x4 __attribute__((ext_vector_type(4)));
typedef unsigned u32x2 __attribute__((ext_vector_type(2)));
typedef __bf16 bf2_t __attribute__((ext_vector_type(2)));
#define MFMA(a, b, c) __builtin_amdgcn_mfma_f32_32x32x16_bf16((a), (b), (c), 0, 0, 0)

constexpr int MP = 32768, MS = 256, MT = 33024;
constexpr int DM = 1024, DFF = 2816;
constexpr float LOG2E = 1.4426950408889634f;
constexpr float EPSN = 1e-6f;
constexpr int NT = 512, NW = 8;
constexpr int KVS = 1088;

constexpr size_t OFF_CTRL = 0;
constexpr size_t OFF_BAR = 4096;
constexpr size_t OFF_ROPE = 20480;
constexpr size_t OFF_WT_FFN_IN = OFF_ROPE + 262144;
constexpr size_t OFF_WT_FFN_OUT = OFF_WT_FFN_IN + 92274688;
constexpr size_t OFF_WT_IN_EVEN = OFF_WT_FFN_OUT + 46137344;
constexpr size_t OFF_WT_OUT_EVEN = OFF_WT_IN_EVEN + 11534336;
constexpr size_t OFF_WT_IN_ODD = OFF_WT_OUT_EVEN + 4194304;
constexpr size_t OFF_WT_OUT_ODD = OFF_WT_IN_ODD + 12582912;
constexpr size_t OFF_WT_GATES = OFF_WT_OUT_ODD + 4194304;
constexpr size_t OFF_SACC = OFF_WT_GATES + 524288;
constexpr size_t OFF_HN = OFF_SACC + 1048576;
constexpr size_t OFF_OUT = OFF_HN + 67633152;
constexpr size_t OFF_KS = OFF_OUT + 67633152;
constexpr size_t OFF_VS = OFF_KS + 35651584;
constexpr size_t OFF_R = OFF_VS + 35651584;
constexpr size_t R_ACT = OFF_R;
constexpr size_t R_U = OFF_R;
constexpr size_t R_G = R_U + 67633152;
constexpr size_t R_QE = R_G + 33816576;
constexpr size_t R_KE = R_QE + 33816576;
constexpr size_t R_VE = R_KE + 33554432;
constexpr size_t R_LOGF = R_VE + 33554432;
constexpr size_t R_CBP = R_LOGF + 1056768;
constexpr size_t R_CBS = R_CBP + 1048576;
constexpr size_t R_UC = R_CBS + 557056;
constexpr size_t R_LA = R_UC + 33816576;
constexpr size_t R_IU = R_LA + 67633152;
constexpr size_t R_SEGA = R_IU + 67633152;
constexpr size_t R_SEGB = R_SEGA + 1081344;
constexpr size_t R_EVEN_END = R_SEGB + 1081344;
constexpr size_t R_QO = OFF_R;
constexpr size_t R_KO = R_QO + 67633152;
constexpr size_t R_VO = R_KO + 67108864;
constexpr size_t R_O1 = R_VO + 67108864;
constexpr size_t R_ODD_END = R_O1 + 135266304;
constexpr size_t WS_NEEDED = (R_EVEN_END > R_ODD_END ? R_EVEN_END : R_ODD_END);

constexpr size_t O_Y = 0;
constexpr size_t O_PFK = O_Y + (size_t)MT * 1024;
constexpr size_t O_PFV = O_PFK + 33554432;
constexpr size_t O_PFL = O_PFV + 33554432;
constexpr size_t O_PLH = O_PFL + 524288;
constexpr size_t O_PLC = O_PLH + 8192;
constexpr size_t O_PDK = O_PLC + 24576;
constexpr size_t O_PDV = O_PDK + 67108864;
constexpr size_t O_SFK = O_PDV + 67108864;
constexpr size_t O_SFV = O_SFK + 262144;
constexpr size_t O_SFL = O_SFV + 262144;
constexpr size_t O_SLH = O_SFL + 4096;
constexpr size_t O_SLC = O_SLH + 16384;
constexpr size_t O_SDK = O_SLC + 49152;
constexpr size_t O_SDV = O_SDK + 524288;

enum { I_XP = 0, I_XS, I_CFK, I_CFV, I_CFL, I_SLH, I_SLC, I_CDK, I_CDV, I_NG, I_WFI, I_WFO, I_WIE, I_BFF, I_CW, I_CB, I_WG, I_BG,
       I_LAM, I_WOE, I_WIO, I_DLAM, I_SUBG, I_WOO };

struct Params {
    const float* in[24];
    float* out;
    char* ws;
};

__shared__ __attribute__((aligned(16))) char smem[131072];

DI int tid_opaque() { int t = threadIdx.x; asm volatile("" : "+v"(t)); return t; }
#define TIDX tid_opaque()
DI float bf2f(bf16_t x) { return __uint_as_float(((unsigned)x) << 16); }
DI unsigned pk2(float lo, float hi) { f32x2 v = {lo, hi}; bf2_t b = __builtin_convertvector(v, bf2_t); return __builtin_bit_cast(unsigned, b); }
DI bf16_t f2bf(float x) { return (bf16_t)(pk2(x, 0.f) & 0xffffu); }
DI float wave_sum(float v) {
#pragma unroll
    for (int o = 32; o >= 1; o >>= 1) v += __shfl_xor(v, o);
    return v;
}
DI float sigmoidf_(float x) { return 1.0f / (1.0f + __expf(-x)); }
DI float softplusf_(float x) { return fmaxf(x, 0.f) + log1pf(__expf(-fabsf(x))); }
DI float gelu_tanh(float x) { const float u = 0.7978845608028654f * (x + 0.044715f * x * x * x); return x / (1.0f + __expf(-2.0f * u)); }
DI int crow(int i, int hh) { return (i & 3) + 8 * (i >> 2) + 4 * hh; }

struct WtJob { const float* src; bf16_t* dst; int K, Ns, mode, p0, k0; };
DI WtJob wt_decode(const Params& P, int t) {
    int tt = t, g;
    if (tt < 11264) g = 0; else if ((tt -= 11264) < 5632) g = 1; else if ((tt -= 5632) < 1408) g = 2; else if ((tt -= 1408) < 512) g = 3;
    else if ((tt -= 512) < 1536) g = 4; else { tt -= 1536; g = 5; }
    const float* src; bf16_t* dst; int K = 1024, Ns = 1024, Nd = 1024, mode = 0;
    switch (g) {
        case 0: src = P.in[I_WFI]; dst = (bf16_t*)(P.ws + OFF_WT_FFN_IN); mode = 1; Ns = 5632; Nd = 5632; break;
        case 1: src = P.in[I_WFO]; dst = (bf16_t*)(P.ws + OFF_WT_FFN_OUT); K = 2816; break;
        case 2: src = P.in[I_WIE]; dst = (bf16_t*)(P.ws + OFF_WT_IN_EVEN); Ns = 2568; Nd = 2816; break;
        case 3: src = P.in[I_WOE]; dst = (bf16_t*)(P.ws + OFF_WT_OUT_EVEN); break;
        case 4: src = P.in[I_WIO]; dst = (bf16_t*)(P.ws + OFF_WT_IN_ODD); Ns = 3072; Nd = 3072; break;
        default: src = P.in[I_WOO]; dst = (bf16_t*)(P.ws + OFF_WT_OUT_ODD); break;
    }
    const int npt = Nd / 64, tpm = npt * (K / 64);
    const int mat = tt / tpm, ti = tt % tpm;
    WtJob j; j.src = src + (size_t)mat * K * Ns; j.dst = dst + (size_t)mat * Nd * K; j.K = K; j.Ns = Ns; j.mode = mode; j.p0 = (ti % npt) * 64; j.k0 = (ti / npt) * 64;
    return j;
}
DI void wt_load(const WtJob& j, float (&v)[8]) {
    const int tid = TIDX;
#pragma unroll
    for (int q = 0; q < 8; ++q) {
        const int idx = tid + NT * q, kk = idx >> 6, pp = idx & 63, p = j.p0 + pp;
        int col = p;
        if (j.mode == 1) { const int pn = p >> 8, w = p & 255; col = ((w >> 5) & 1) * DFF + pn * 128 + (w >> 6) * 32 + (w & 31); }
        v[q] = (col < j.Ns) ? j.src[(size_t)(j.k0 + kk) * j.Ns + col] : 0.f;
    }
}
DI void wt_store(const WtJob& j, const float (&v)[8]) {
    float* T = (float*)smem;
    const int tid = TIDX;
#pragma unroll
    for (int q = 0; q < 8; ++q) { const int idx = tid + NT * q; T[(idx >> 6) * 65 + (idx & 63)] = v[q]; }
    __syncthreads();
    {
        const int pp = tid >> 3, ks = (tid & 7) * 8;
        unsigned w[4];
#pragma unroll
        for (int q = 0; q < 4; ++q) w[q] = pk2(T[(ks + 2 * q) * 65 + pp], T[(ks + 2 * q + 1) * 65 + pp]);
        *(u32x4*)(j.dst + (size_t)(j.p0 + pp) * j.K + j.k0 + ks) = (u32x4){w[0], w[1], w[2], w[3]};
    }
    __syncthreads();
}

DI void phase_prologue(const Params& P) {
    const int total = 20864;
    {
        int t = blockIdx.x;
        WtJob job{}; float cur[8];
        if (t < total) { job = wt_decode(P, t); wt_load(job, cur); }
        for (; t < total; t += gridDim.x) {
            const int tn = t + gridDim.x;
            WtJob jobn = job; float nxt[8];
            if (tn < total) { jobn = wt_decode(P, tn); wt_load(jobn, nxt); }
            else {
#pragma unroll
                for (int q = 0; q < 8; ++q) nxt[q] = 0.f;
            }
            wt_store(job, cur);
            job = jobn;
#pragma unroll
            for (int q = 0; q < 8; ++q) cur[q] = nxt[q];
        }
    }
    {
        bf16_t* wgx = (bf16_t*)(P.ws + OFF_WT_GATES);
        const float* wg = P.in[I_WG];
        for (int idx = blockIdx.x * NT + TIDX; idx < 2 * 4 * 256 * 128; idx += gridDim.x * NT) {
            const int k = idx & 127, n = (idx >> 7) & 255, pr = (idx >> 15) & 3, e = idx >> 17;
            float v = 0.f;
            if (n < 128) { if (k < 64) v = wg[((size_t)(e * 8 + 2 * pr) * 64 + k) * 128 + n]; }
            else { if (k >= 64) v = wg[((size_t)(e * 8 + 2 * pr + 1) * 64 + (k - 64)) * 128 + (n - 128)]; }
            wgx[idx] = f2bf(v);
        }
        float* sacc = (float*)(P.ws + OFF_SACC);
        for (int idx = blockIdx.x * NT + TIDX; idx < 256 * 1024; idx += gridDim.x * NT) sacc[idx] = 0.f;
    }
    {
        float* rc = (float*)(P.ws + OFF_ROPE); float* rs = rc + 32768;
        for (int idx = blockIdx.x * NT + TIDX; idx < 32768; idx += gridDim.x * NT) {
            const int pos = idx >> 3, i = idx & 7;
            const float inv = powf(500000.0f, -0.125f * (float)i);
            const float ang = (float)pos * inv;
            const double x = (double)ang;
            const double k = rint(x * 0.15915494309189535);
            const float rr = (float)(x - k * 6.283185307179586);
            rc[idx] = __cosf(rr); rs[idx] = __sinf(rr);
        }
    }
}

DI void phase_norm(const Params& P, int mode, float scale, const float* __restrict__ g_post, const float* __restrict__ g_next) {
    const int lane = TIDX & 63, wave = TIDX >> 6;
    float* X = P.out + O_Y;
    bf16_t* HN = (bf16_t*)(P.ws + OFF_HN);
    const bf16_t* OUT = (const bf16_t*)(P.ws + OFF_OUT);
    for (int row = blockIdx.x * NW + wave; row < MT; row += gridDim.x * NW) {
        f32x4 xv[4];
        if (mode == 0) {
            const float* src = row < MP ? P.in[I_XP] + (size_t)row * DM : P.in[I_XS] + (size_t)(row - MP) * DM;
#pragma unroll
            for (int i = 0; i < 4; ++i) xv[i] = *(const f32x4*)(src + lane * 4 + 256 * i);
        } else {
            f32x4 ov[4], xo[4]; float ss = 0.f;
#pragma unroll
            for (int i = 0; i < 4; ++i) xo[i] = *(const f32x4*)(X + (size_t)row * DM + lane * 4 + 256 * i);
#pragma unroll
            for (int i = 0; i < 4; ++i) {
                if (row < MP) {
                    const u32x2 w = *(const u32x2*)(OUT + (size_t)row * DM + lane * 4 + 256 * i);
                    ov[i] = (f32x4){__uint_as_float(w.x << 16), __uint_as_float(w.x & 0xffff0000u), __uint_as_float(w.y << 16), __uint_as_float(w.y & 0xffff0000u)};
                } else {
                    float* sp = (float*)(P.ws + OFF_SACC) + (size_t)(row - MP) * DM + lane * 4 + 256 * i;
                    ov[i] = *(const f32x4*)sp;
                    *(f32x4*)sp = (f32x4){0.f, 0.f, 0.f, 0.f};
                }
                ss += ov[i].x * ov[i].x + ov[i].y * ov[i].y + ov[i].z * ov[i].z + ov[i].w * ov[i].w;
            }
            ss = wave_sum(ss);
            const float rstd = rsqrtf(ss * (1.0f / 1024.0f) + EPSN) * scale;
#pragma unroll
            for (int i = 0; i < 4; ++i) {
                const f32x4 gp = *(const f32x4*)(g_post + lane * 4 + 256 * i);
                xv[i] = xo[i] + ov[i] * rstd * gp;
            }
        }
#pragma unroll
        for (int i = 0; i < 4; ++i) *(f32x4*)(X + (size_t)row * DM + lane * 4 + 256 * i) = xv[i];
        if (g_next) {
            float ss = 0.f;
#pragma unroll
            for (int i = 0; i < 4; ++i) ss += xv[i].x * xv[i].x + xv[i].y * xv[i].y + xv[i].z * xv[i].z + xv[i].w * xv[i].w;
            ss = wave_sum(ss);
            const float rstd = rsqrtf(ss * (1.0f / 1024.0f) + EPSN);
#pragma unroll
            for (int i = 0; i < 4; ++i) {
                const f32x4 gn = *(const f32x4*)(g_next + lane * 4 + 256 * i);
                const f32x4 hv = xv[i] * rstd * gn;
                *(u32x2*)(HN + (size_t)row * DM + lane * 4 + 256 * i) = (u32x2){pk2(hv.x, hv.y), pk2(hv.z, hv.w)};
            }
        }
    }
}

DI void cache_prep(const float* __restrict__ ck, const float* __restrict__ cv, bf16_t* __restrict__ KS, bf16_t* __restrict__ VS_, int W) {
    const int cpr = W / 8;
    const int nch = 16 * 1024 * cpr;
    const int gsz = gridDim.x * NT;
    for (int idx0 = blockIdx.x * NT + TIDX; idx0 < 2 * nch; idx0 += 4 * gsz) {
        f32x4 a[4], bb[4]; bf16_t* d[4]; bool ok[4];
#pragma unroll
        for (int u = 0; u < 4; ++u) {
            const int idx = idx0 + u * gsz; ok[u] = idx < 2 * nch;
            const int idc = ok[u] ? idx : idx0;
            const int which = idc >= nch; const int id = which ? idc - nch : idc;
            const int c = id % cpr, rowg = id / cpr, b = rowg >> 10, k = rowg & 1023;
            const float* sp = (which ? cv : ck) + (size_t)rowg * W + c * 8;
            a[u] = *(const f32x4*)sp; bb[u] = *(const f32x4*)(sp + 4);
            d[u] = (which ? VS_ : KS) + ((size_t)(b * KVS + k)) * W + c * 8;
        }
#pragma unroll
        for (int u = 0; u < 4; ++u)
            if (ok[u]) *(u32x4*)d[u] = (u32x4){pk2(a[u].x, a[u].y), pk2(a[u].z, a[u].w), pk2(bb[u].x, bb[u].y), pk2(bb[u].z, bb[u].w)};
    }
    const int nz = 16 * 48 * cpr;
    for (int idx = blockIdx.x * NT + TIDX; idx < 2 * nz; idx += gridDim.x * NT) {
        const int which = idx >= nz; const int id = which ? idx - nz : idx;
        const int c = id % cpr, rowg = id / cpr, b = rowg / 48, k = 1040 + rowg % 48;
        bf16_t* d = (which ? VS_ : KS) + ((size_t)(b * KVS + k)) * W + c * 8;
        *(u32x4*)d = (u32x4){0u, 0u, 0u, 0u};
    }
}

struct GemmArgs { const bf16_t* A; int lda; int a_pn_stride; const bf16_t* Bt; int K; int nM, nN; int nsk, skc; };
enum { EPI_PLAIN = 0, EPI_SWIGLU, EPI_EVEN_IN, EPI_GATES, EPI_ODD_IN, EPI_SACC };

DI bool gemm_next(int it, int nM, int nN, int& pm, int& pn) {
    const int G = gridDim.x;
    if ((G & 7) == 0) {
        const int x = blockIdx.x & 7, bl = blockIdx.x >> 3, bpx = G >> 3, j = bl + it * bpx;
        const int nMx = (nM - x + 7) >> 3;
        if (j >= nMx * nN) return false;
        const int grp = j / (8 * nN), within = j % (8 * nN);
        int gsz = nMx - grp * 8; if (gsz > 8) gsz = 8;
        pn = within / gsz; pm = x + 8 * (grp * 8 + within % gsz);
        return true;
    } else {
        const int t = blockIdx.x + it * G;
        if (t >= nM * nN) return false;
        pm = t / nN; pn = t % nN; return true;
    }
}

template <int EPI>
DI void gemm_epilogue(const Params& P, int li, const f32x16 (&acc)[4][2], int pm, int pn, bf16_t* __restrict__ C, int ldc) {
    const int tid = TIDX, lane = tid & 63, wave = tid >> 6, wr = wave >> 2, wc = wave & 3, r = lane & 31, hh = lane >> 5;
    const int m0 = pm * 256 + wr * 128;
    const bool samp = pm * 256 >= MP;
    if (EPI == EPI_PLAIN) {
#pragma unroll
        for (int mt = 0; mt < 4; ++mt)
#pragma unroll
            for (int i = 0; i < 16; ++i) {
                const int row = m0 + mt * 32 + crow(i, hh);
#pragma unroll
                for (int nt = 0; nt < 2; ++nt) C[(size_t)row * ldc + pn * 256 + wc * 64 + nt * 32 + r] = f2bf(acc[mt][nt][i]);
            }
    } else if (EPI == EPI_SACC) {
        float* S = (float*)(P.ws + OFF_SACC);
#pragma unroll
        for (int mt = 0; mt < 4; ++mt)
#pragma unroll
            for (int i = 0; i < 16; ++i) {
                const int row = wr * 128 + mt * 32 + crow(i, hh);
#pragma unroll
                for (int nt = 0; nt < 2; ++nt) atomicAdd(S + (size_t)row * DM + pn * 256 + wc * 64 + nt * 32 + r, acc[mt][nt][i]);
            }
    } else if (EPI == EPI_SWIGLU) {
        const int j = pn * 128 + wc * 32 + r;
#pragma unroll
        for (int mt = 0; mt < 4; ++mt)
#pragma unroll
            for (int i = 0; i < 16; ++i) {
                const int row = m0 + mt * 32 + crow(i, hh);
                const float g = acc[mt][0][i], u = acc[mt][1][i];
                C[(size_t)row * DFF + j] = f2bf(g / (1.0f + __expf(-g)) * u);
            }
    } else if (EPI == EPI_EVEN_IN) {
        const int e = li;
        const int sec = (pn * 256) >> 9;
        const int cb0 = ((pn * 256) & 511) + wc * 64 + r;
        if (sec == 0) {
            float* U = (float*)(P.ws + R_U);
#pragma unroll
            for (int mt = 0; mt < 4; ++mt)
#pragma unroll
                for (int i = 0; i < 16; ++i) {
                    const int row = m0 + mt * 32 + crow(i, hh);
#pragma unroll
                    for (int nt = 0; nt < 2; ++nt) U[(size_t)row * 512 + cb0 + nt * 32] = acc[mt][nt][i];
                }
        } else if (sec == 1) {
            bf16_t* Gb = (bf16_t*)(P.ws + R_G);
#pragma unroll
            for (int mt = 0; mt < 4; ++mt)
#pragma unroll
                for (int i = 0; i < 16; ++i) {
                    const int row = m0 + mt * 32 + crow(i, hh);
#pragma unroll
                    for (int nt = 0; nt < 2; ++nt) Gb[(size_t)row * 512 + cb0 + nt * 32] = f2bf(gelu_tanh(acc[mt][nt][i]));
                }
        } else if (sec == 2) {
            bf16_t* QE = (bf16_t*)(P.ws + R_QE);
#pragma unroll
            for (int mt = 0; mt < 4; ++mt)
#pragma unroll
                for (int i = 0; i < 16; ++i) {
                    const int row = m0 + mt * 32 + crow(i, hh);
#pragma unroll
                    for (int nt = 0; nt < 2; ++nt) QE[(size_t)row * 512 + cb0 + nt * 32] = f2bf(acc[mt][nt][i] * (0.125f * LOG2E));
                }
        } else if (sec == 3 || sec == 4) {
            bf16_t* bb; float* ob;
            if (!samp) { bb = (bf16_t*)(P.ws + (sec == 3 ? R_KE : R_VE)); ob = P.out + (sec == 3 ? O_PFK : O_PFV) + (size_t)e * (8 * 4096 * 512); }
            else { bb = (bf16_t*)(P.ws + (sec == 3 ? OFF_KS : OFF_VS)); ob = P.out + (sec == 3 ? O_SFK : O_SFV) + (size_t)e * (16 * 16 * 512); }
#pragma unroll
            for (int mt = 0; mt < 4; ++mt)
#pragma unroll
                for (int i = 0; i < 16; ++i) {
                    const int row = m0 + mt * 32 + crow(i, hh);
                    const int mm = row - MP;
                    const size_t rb = samp ? (size_t)((mm >> 4) * KVS + 1024 + (mm & 15)) : (size_t)row;
                    const size_t ro = samp ? (size_t)mm : (size_t)row;
#pragma unroll
                    for (int nt = 0; nt < 2; ++nt) {
                        const float v = acc[mt][nt][i];
                        bb[rb * 512 + cb0 + nt * 32] = f2bf(v);
                        ob[ro * 512 + cb0 + nt * 32] = v;
                    }
                }
        } else {
            float* LF = (float*)(P.ws + R_LOGF);
            if (cb0 < 8) {
                const float bf_ = P.in[I_BFF][e * 8 + cb0];
#pragma unroll
                for (int mt = 0; mt < 4; ++mt)
#pragma unroll
                    for (int i = 0; i < 16; ++i) {
                        const int row = m0 + mt * 32 + crow(i, hh);
                        const int mm = row - MP;
                        const float lf = -softplusf_(-(acc[mt][0][i] + bf_));
                        LF[(size_t)row * 8 + cb0] = lf;
                        if (!samp) P.out[O_PFL + (size_t)e * (8 * 4096 * 8) + (size_t)row * 8 + cb0] = lf;
                        else P.out[O_SFL + (size_t)e * (16 * 16 * 8) + (size_t)mm * 8 + cb0] = lf;
                    }
            }
        }
    } else if (EPI == EPI_GATES) {
        const int e = li, blk = 2 * pn + (wc >> 1);
        float* LA = (float*)(P.ws + R_LA); float* IU = (float*)(P.ws + R_IU); const bf16_t* UC = (const bf16_t*)(P.ws + R_UC);
#pragma unroll
        for (int nt = 0; nt < 2; ++nt) {
            const int n = (wc & 1) * 64 + nt * 32 + r, ch = blk * 64 + (n & 63);
            const float bias = P.in[I_BG][(e * 8 + blk) * 128 + n];
            const float sp = softplusf_(-P.in[I_LAM][e * 512 + ch]);
#pragma unroll
            for (int mt = 0; mt < 4; ++mt)
#pragma unroll
                for (int i = 0; i < 16; ++i) {
                    const int row = m0 + mt * 32 + crow(i, hh);
                    const float sg = sigmoidf_(acc[mt][nt][i] + bias);
                    if ((wc & 1) == 0) LA[(size_t)row * 512 + ch] = -8.0f * sg * sp;
                    else IU[(size_t)row * 512 + ch] = sg * bf2f(UC[(size_t)row * 512 + ch]);
                }
        }
    } else if (EPI == EPI_ODD_IN) {
        const int o = li;
        const int sec = (pn * 256) >> 10;
        bf16_t* QO = (bf16_t*)(P.ws + R_QO); bf16_t* KO = (bf16_t*)(P.ws + R_KO); bf16_t* VO = (bf16_t*)(P.ws + R_VO);
        bf16_t* KSb = (bf16_t*)(P.ws + OFF_KS); bf16_t* VSb = (bf16_t*)(P.ws + OFF_VS);
        const float* rc = (const float*)(P.ws + OFF_ROPE); const float* rs = rc + 32768;
#pragma unroll
        for (int mt = 0; mt < 4; ++mt)
#pragma unroll
            for (int i = 0; i < 16; ++i) {
                const int row = m0 + mt * 32 + crow(i, hh);
                const int mm = row - MP;
                const int pos = samp ? 1024 + (mm & 15) : (row & 4095);
#pragma unroll
                for (int nt = 0; nt < 2; ++nt) {
                    const int c = ((pn * 256) & 1023) + wc * 64 + nt * 32 + r;
                    float v = acc[mt][nt][i];
                    if (sec < 2 && nt == 0) {
                        const float other = __shfl_xor(v, 8);
                        const float cs = rc[pos * 8 + (r & 7)], sn = rs[pos * 8 + (r & 7)];
                        if (r < 8) v = v * cs - other * sn;
                        else if (r < 16) v = v * cs + other * sn;
                    }
                    if (sec == 0) QO[(size_t)row * 1024 + c] = f2bf(v * (0.125f * LOG2E));
                    else {
                        bf16_t* dstb; float* dsto;
                        if (!samp) {
                            dstb = (sec == 1 ? KO : VO) + (size_t)row * 1024 + c;
                            dsto = P.out + (sec == 1 ? O_PDK : O_PDV) + (size_t)o * (8 * 4096 * 1024) + (size_t)row * 1024 + c;
                        } else {
                            dstb = (sec == 1 ? KSb : VSb) + ((size_t)((mm >> 4) * KVS + 1024 + (mm & 15))) * 1024 + c;
                            dsto = P.out + (sec == 1 ? O_SDK : O_SDV) + (size_t)o * (16 * 16 * 1024) + (size_t)mm * 1024 + c;
                        }
                        *dstb = f2bf(v); *dsto = v;
                    }
                }
            }
    }
}

template <bool QUARTER>
DI void gemm_tile_loop(const bf16_t* __restrict__ Ap, int lda, const bf16_t* __restrict__ Bp, int ldb, int ks0, int nks, f32x16 (&acc)[4][2], int q = 0) {
    const int tid = TIDX, lane = tid & 63, wave = tid >> 6, wr = wave >> 2, wc = wave & 3, r = lane & 31, hh = lane >> 5;
    const int sc = tid & 7, sr = tid >> 3;
    LDS char* sm = (LDS char*)smem;
#pragma unroll
    for (int a = 0; a < 4; ++a)
#pragma unroll
        for (int b = 0; b < 2; ++b)
#pragma unroll
            for (int i = 0; i < 16; ++i) acc[a][b][i] = 0.f;
    const unsigned aoff = (unsigned)(sr * lda + sc * 8) * 2u, astep = (unsigned)(64 * lda) * 2u;
    const unsigned boff = (unsigned)(sr * ldb + sc * 8) * 2u, bstep = (unsigned)(64 * ldb) * 2u;
    const int soff = sr * 128 + ((sc ^ ((sr >> 1) & 7)) << 4);
    const char* ap = (const char*)Ap + (size_t)ks0 * 128;
    const char* bp = (const char*)Bp + (size_t)ks0 * 128;
    u32x4 r0a[4], r0b[4], r1a[4], r1b[4];
    auto gload = [&](u32x4 (&ra)[4], u32x4 (&rb)[4], int st) {
        const char* a = ap + (size_t)st * 128; const char* b = bp + (size_t)st * 128;
#pragma unroll
        for (int i = 0; i < 4; ++i) { ra[i] = *(const u32x4*)(a + aoff + i * astep); rb[i] = *(const u32x4*)(b + boff + i * bstep); }
    };
    auto swrite = [&](const u32x4 (&ra)[4], const u32x4 (&rb)[4], int buf) {
#pragma unroll
        for (int i = 0; i < 4; ++i) { *(LDS u32x4*)(sm + buf * 65536 + soff + i * 8192) = ra[i]; *(LDS u32x4*)(sm + buf * 65536 + 32768 + soff + i * 8192) = rb[i]; }
    };
    const int arow = QUARTER ? (wave * 32 + r) * 128 : (wr * 128 + r) * 128, brow = 32768 + ((QUARTER ? q : wc) * 64 + r) * 128, swz = (r >> 1) & 7;
    auto compute = [&](int buf) {
#pragma unroll
        for (int ks = 0; ks < 4; ++ks) {
            const int ch = (((ks << 1) | hh) ^ swz) << 4;
            bf16x8 af[4], bfr[2];
#pragma unroll
            for (int t = 0; t < (QUARTER ? 1 : 4); ++t) af[t] = *(LDS bf16x8*)(sm + buf * 65536 + arow + t * 4096 + ch);
#pragma unroll
            for (int t = 0; t < 2; ++t) bfr[t] = *(LDS bf16x8*)(sm + buf * 65536 + brow + t * 4096 + ch);
#pragma unroll
            for (int mt = 0; mt < (QUARTER ? 1 : 4); ++mt)
#pragma unroll
                for (int nt = 0; nt < 2; ++nt) acc[mt][nt] = MFMA(af[mt], bfr[nt], acc[mt][nt]);
        }
    };
    gload(r0a, r0b, 0);
    if (nks > 1) gload(r1a, r1b, 1);
    swrite(r0a, r0b, 0);
    __syncthreads();
    if (nks > 2) gload(r0a, r0b, 2);
    for (int kt = 0; kt < nks; kt += 2) {
        compute(0);
        if (kt + 1 < nks) swrite(r1a, r1b, 1);
        __syncthreads();
        if (kt + 3 < nks) gload(r1a, r1b, kt + 3);
        if (kt + 1 < nks) {
            compute(1);
            if (kt + 2 < nks) swrite(r0a, r0b, 0);
            __syncthreads();
            if (kt + 4 < nks) gload(r0a, r0b, kt + 4);
        }
    }
}

template <int EPI>
DI void gemm_phase(const Params& P, int li, const GemmArgs g, bf16_t* __restrict__ C, int ldc) {
    int pm, pn, it = 0;
    for (; gemm_next(it, g.nM, g.nN, pm, pn); ++it) {
        const bf16_t* Ap = g.A + (size_t)(pm * 256) * g.lda + (size_t)pn * g.a_pn_stride;
        const bf16_t* Bp = g.Bt + (size_t)(pn * 256) * g.K;
        f32x16 acc[4][2];
        gemm_tile_loop<false>(Ap, g.lda, Bp, g.K, 0, g.K >> 6, acc);
        gemm_epilogue<EPI>(P, li, acc, pm, pn, C, ldc);
        if (EPI == EPI_GATES) {
            __syncthreads();
            const float* LA = (const float*)(P.ws + R_LA); const float* IU = (const float*)(P.ws + R_IU);
            float* SA = (float*)(P.ws + R_SEGA); float* SB = (float*)(P.ws + R_SEGB);
            const bool smp = pm == 128;
            const int nit = (smp ? 16 : 4) * 128, len = smp ? 16 : 64;
            for (int item = TIDX; item < nit; item += NT) {
                const int sl = item >> 7, ch = pn * 128 + (item & 127);
                const int seg = smp ? 512 + sl : pm * 4 + sl, row0 = smp ? MP + sl * 16 : pm * 256 + sl * 64;
                float h = 0.f, p = 1.f;
                for (int j0 = 0; j0 < len; j0 += 8) {
                    float la[8], iu[8];
#pragma unroll
                    for (int j = 0; j < 8; ++j) { la[j] = LA[(size_t)(row0 + j0 + j) * 512 + ch]; iu[j] = IU[(size_t)(row0 + j0 + j) * 512 + ch]; }
#pragma unroll
                    for (int j = 0; j < 8; ++j) {
                        const float a = __expf(la[j]), bx = sqrtf(-expm1f(2.0f * la[j])) * iu[j];
                        h = a * h + bx; p *= a;
                    }
                }
                SA[seg * 512 + ch] = p; SB[seg * 512 + ch] = h;
            }
        }
    }
    if (EPI == EPI_SWIGLU) {
        const int tid = TIDX, lane = tid & 63, wave = tid >> 6, r = lane & 31, hh = lane >> 5;
        for (int j = (int)gridDim.x - 1 - (int)blockIdx.x; j < g.nsk; j += gridDim.x) {
            const int pn2 = j >> 2, q = j & 3;
            const bf16_t* Ap = g.A + (size_t)MP * g.lda;
            const bf16_t* Bp = g.Bt + (size_t)(pn2 * 256) * g.K;
            f32x16 acc[4][2];
            gemm_tile_loop<true>(Ap, g.lda, Bp, g.K, 0, g.K >> 6, acc, q);
            const int jc = pn2 * 128 + q * 32 + r;
#pragma unroll
            for (int i = 0; i < 16; ++i) {
                const int row = MP + wave * 32 + crow(i, hh);
                const float gv = acc[0][0][i], uv = acc[0][1][i];
                C[(size_t)row * DFF + jc] = f2bf(gv / (1.0f + __expf(-gv)) * uv);
            }
        }
    }
    if (EPI == EPI_PLAIN) {
        for (int j = (int)gridDim.x - 1 - (int)blockIdx.x; j < g.nsk; j += gridDim.x) {
            const int pn2 = j % g.nN, kc = j / g.nN;
            const bf16_t* Ap = g.A + (size_t)MP * g.lda;
            const bf16_t* Bp = g.Bt + (size_t)(pn2 * 256) * g.K;
            f32x16 acc[4][2];
            gemm_tile_loop<false>(Ap, g.lda, Bp, g.K, kc * g.skc, g.skc, acc);
            gemm_epilogue<EPI_SACC>(P, li, acc, 128, pn2, nullptr, 0);
        }
    }
}

DI void phase_conv(const Params& P, int e) {
    const float* __restrict__ U = (const float*)(P.ws + R_U);
    bf16_t* __restrict__ UC = (bf16_t*)(P.ws + R_UC);
    const float* cw = P.in[I_CW] + e * 4 * 512; const float* cbias = P.in[I_CB] + e * 512;
    const float* sbuf = P.in[I_SLC] + (size_t)e * 16 * 3 * 512;
    const int gtid = blockIdx.x * NT + TIDX, gsz = gridDim.x * NT;
    for (int idx = gtid; idx < MT * 128; idx += gsz) {
        const int row = idx >> 7, c = (idx & 127) * 4;
        int t, b; const bool samp = row >= MP;
        if (!samp) { t = row & 4095; b = row >> 12; } else { t = (row - MP) & 15; b = (row - MP) >> 4; }
        f32x4 acc = *(const f32x4*)(cbias + c);
#pragma unroll
        for (int j = 0; j < 4; ++j) {
            const int tt = t - 3 + j;
            f32x4 uv;
            if (tt >= 0) uv = *(const f32x4*)(U + (size_t)(row - 3 + j) * 512 + c);
            else if (samp) uv = *(const f32x4*)(sbuf + ((size_t)b * 3 + (3 + tt)) * 512 + c);
            else uv = (f32x4){0.f, 0.f, 0.f, 0.f};
            acc += uv * *(const f32x4*)(cw + j * 512 + c);
        }
        *(u32x2*)(UC + (size_t)row * 512 + c) = (u32x2){pk2(acc.x, acc.y), pk2(acc.z, acc.w)};
    }
    for (int idx = gtid; idx < (8 + 16) * 3 * 512; idx += gsz) {
        const int c = idx & 511, i = (idx >> 9) % 3, s = idx / 1536;
        if (s < 8) P.out[O_PLC + ((size_t)(e * 8 + s) * 3 + i) * 512 + c] = U[(size_t)(s * 4096 + 4093 + i) * 512 + c];
        else P.out[O_SLC + ((size_t)(e * 16 + (s - 8)) * 3 + i) * 512 + c] = U[(size_t)(MP + (s - 8) * 16 + 13 + i) * 512 + c];
    }
    const float* LF = (const float*)(P.ws + R_LOGF);
    float* CBP = (float*)(P.ws + R_CBP); float* CBS = (float*)(P.ws + R_CBS);
    const int lane = TIDX & 63;
    for (int w = blockIdx.x * NW + (TIDX >> 6); w < 64 + 128; w += gridDim.x * NW) {
        if (w < 64) {
            const int s = w >> 3, h = w & 7;
            float loc = 0.f;
            for (int j0 = 0; j0 < 64; j0 += 16) {
                float v[16];
#pragma unroll
                for (int j = 0; j < 16; ++j) v[j] = LF[(size_t)(s * 4096 + lane * 64 + j0 + j) * 8 + h];
#pragma unroll
                for (int j = 0; j < 16; ++j) loc += v[j];
            }
            float inc = loc;
#pragma unroll
            for (int o = 1; o < 64; o <<= 1) { const float t = __shfl_up(inc, o); if (lane >= o) inc += t; }
            float run = inc - loc;
            for (int j0 = 0; j0 < 64; j0 += 16) {
                float v[16];
#pragma unroll
                for (int j = 0; j < 16; ++j) v[j] = LF[(size_t)(s * 4096 + lane * 64 + j0 + j) * 8 + h];
#pragma unroll
                for (int j = 0; j < 16; ++j) { run += v[j]; v[j] = -run * LOG2E; }
#pragma unroll
                for (int j = 0; j < 16; ++j) CBP[(size_t)(s * 8 + h) * 4096 + lane * 64 + j0 + j] = v[j];
            }
        } else {
            const int b = (w - 64) >> 3, h = (w - 64) & 7;
            const float* cl = P.in[I_CFL] + (size_t)(e * 16 + b) * 1024 * 8;
            float loc = 0.f;
            for (int j = 0; j < 17; ++j) {
                const int k = lane * 17 + j;
                float v = 0.f;
                if (k < 1024) v = cl[(size_t)k * 8 + h]; else if (k < 1040) v = LF[(size_t)(MP + b * 16 + (k - 1024)) * 8 + h];
                loc += v;
            }
            float inc = loc;
#pragma unroll
            for (int o = 1; o < 64; o <<= 1) { const float t = __shfl_up(inc, o); if (lane >= o) inc += t; }
            float run = inc - loc;
            for (int j = 0; j < 17; ++j) {
                const int k = lane * 17 + j;
                float v = 0.f;
                if (k < 1024) v = cl[(size_t)k * 8 + h]; else if (k < 1040) v = LF[(size_t)(MP + b * 16 + (k - 1024)) * 8 + h];
                run += v;
                CBS[(size_t)(b * 8 + h) * KVS + k] = -run * LOG2E;
            }
        }
    }
}

DI void seg_info(int seg, int& row0, int& len) { if (seg < 512) { row0 = seg * 64; len = 64; } else { row0 = MP + (seg - 512) * 16; len = 16; } }

DI void phase_scan1(const Params& P) {
    const float* LA = (const float*)(P.ws + R_LA); const float* IU = (const float*)(P.ws + R_IU);
    float* SA = (float*)(P.ws + R_SEGA); float* SB = (float*)(P.ws + R_SEGB);
    for (int idx = blockIdx.x * NT + TIDX; idx < 528 * 512; idx += gridDim.x * NT) {
        const int seg = idx >> 9, c = idx & 511;
        int row0, len; seg_info(seg, row0, len);
        float h = 0.f, p = 1.f;
        for (int j0 = 0; j0 < len; j0 += 8) {
            float la[8], iu[8];
#pragma unroll
            for (int j = 0; j < 8; ++j) { la[j] = LA[(size_t)(row0 + j0 + j) * 512 + c]; iu[j] = IU[(size_t)(row0 + j0 + j) * 512 + c]; }
#pragma unroll
            for (int j = 0; j < 8; ++j) {
                const float a = __expf(la[j]), bx = sqrtf(-expm1f(2.0f * la[j])) * iu[j];
                h = a * h + bx; p *= a;
            }
        }
        SA[idx] = p; SB[idx] = h;
    }
}

DI void phase_scan3(const Params& P, int e) {
    const float* LA = (const float*)(P.ws + R_LA); const float* IU = (const float*)(P.ws + R_IU);
    const float* SA = (const float*)(P.ws + R_SEGA); const float* SB = (const float*)(P.ws + R_SEGB);
    const bf16_t* Gb = (const bf16_t*)(P.ws + R_G);
    bf16_t* MIX = (bf16_t*)(P.ws + OFF_HN);
    for (int idx = blockIdx.x * NT + TIDX; idx < 528 * 512; idx += gridDim.x * NT) {
        const int seg = idx >> 9, c = idx & 511;
        int row0, len; seg_info(seg, row0, len);
        float h = 0.f;
        if (seg < 512) {
            const int s0 = seg & ~63;
            for (int sb = s0; sb < seg; sb += 8) {
                float sa[8], sbv[8];
#pragma unroll
                for (int j = 0; j < 8; ++j) { const int sj = (sb + j < seg) ? sb + j : s0; sa[j] = SA[sj * 512 + c]; sbv[j] = SB[sj * 512 + c]; }
#pragma unroll
                for (int j = 0; j < 8; ++j) if (sb + j < seg) h = sa[j] * h + sbv[j];
            }
        }
        else h = P.in[I_SLH][(size_t)(e * 16 + (seg - 512)) * 512 + c];
        for (int j0 = 0; j0 < len; j0 += 8) {
            float la[8], iu[8], gg[8], y[8];
#pragma unroll
            for (int j = 0; j < 8; ++j) {
                la[j] = LA[(size_t)(row0 + j0 + j) * 512 + c]; iu[j] = IU[(size_t)(row0 + j0 + j) * 512 + c];
                gg[j] = bf2f(Gb[(size_t)(row0 + j0 + j) * 512 + c]);
            }
#pragma unroll
            for (int j = 0; j < 8; ++j) {
                const float a = __expf(la[j]), bx = sqrtf(-expm1f(2.0f * la[j])) * iu[j];
                h = a * h + bx; y[j] = h * gg[j];
            }
#pragma unroll
            for (int j = 0; j < 8; ++j) MIX[(size_t)(row0 + j0 + j) * 1024 + c] = f2bf(y[j]);
        }
        if (seg < 512) { if ((seg & 63) == 63) P.out[O_PLH + (size_t)(e * 8 + (seg >> 6)) * 512 + c] = h; }
        else P.out[O_SLH + (size_t)(e * 16 + (seg - 512)) * 512 + c] = h;
    }
}

template <int DV, bool BIAS>
DI void flash_pass(const bf16_t* __restrict__ Qb, int ldq, const bf16_t* __restrict__ Kb, int ldk, const bf16_t* __restrict__ Vb, int ldv,
                   const float* __restrict__ cb, int q0, int nq, int past, int mode, int kvlen, f32x16 (&O)[DV / 32], float& l_out) {
    constexpr int VSTR = (DV == 64) ? 192 : 320;
    constexpr int BUFSZ = 8192 + 64 * VSTR + 256;
    constexpr int VCH = DV / 8, NVL = (64 * VCH) / NT;
    const int tid = TIDX, lane = tid & 63, wave = tid >> 6, r = lane & 31, hh = lane >> 5;
    LDS char* sm = (LDS char*)smem;
    const int qw0 = q0 + wave * 32;
    const bool wactive = qw0 < nq;
    int qi = qw0 + r; if (qi > nq - 1) qi = nq - 1;
    const int qabs = past + qi;
    int klim = qabs; if (mode == 1) { klim = qabs | 63; if (klim > kvlen - 1) klim = kvlen - 1; }
    int qlw = qw0 + 31; if (qlw > nq - 1) qlw = nq - 1;
    int wkmax = past + qlw; if (mode == 1) { wkmax |= 63; if (wkmax > kvlen - 1) wkmax = kvlen - 1; }
    const int wkmin = (mode == 0) ? past + qw0 : wkmax;
    int qlb = q0 + NW * 32 - 1; if (qlb > nq - 1) qlb = nq - 1;
    int bkmax = past + qlb; if (mode == 1) { bkmax |= 63; if (bkmax > kvlen - 1) bkmax = kvlen - 1; }
    const int ntiles = (bkmax >> 6) + 1;

    bf16x8 qf[4];
#pragma unroll
    for (int ks = 0; ks < 4; ++ks) qf[ks] = *(const bf16x8*)(Qb + (size_t)qi * ldq + ks * 16 + hh * 8);
#pragma unroll
    for (int dt = 0; dt < DV / 32; ++dt)
#pragma unroll
        for (int i = 0; i < 16; ++i) O[dt][i] = 0.f;
    float m = -1e30f, l = 0.f;

    u32x4 rk[1], rv[NVL]; f32x4 rc4 = {0.f, 0.f, 0.f, 0.f};
    unsigned koff[1], vofs[NVL];
#pragma unroll
    for (int i = 0; i < 1; ++i) { const int idx = tid + NT * i, row = idx >> 3, c = idx & 7; koff[i] = (unsigned)(row * ldk + c * 8) * 2u; }
#pragma unroll
    for (int i = 0; i < NVL; ++i) { const int idx = tid + NT * i, row = idx / VCH, c = idx % VCH; vofs[i] = (unsigned)(row * ldv + c * 8) * 2u; }
    auto prefetch = [&](int kt) {
        const char* kp = (const char*)Kb + (size_t)kt * 128 * ldk;
        const char* vp = (const char*)Vb + (size_t)kt * 128 * ldv;
#pragma unroll
        for (int i = 0; i < 1; ++i) rk[i] = *(const u32x4*)(kp + koff[i]);
        if (DV == 64) {
#pragma unroll
            for (int i = 0; i < NVL; ++i) rv[i] = *(const u32x4*)(vp + vofs[i]);
        }
        if (BIAS) { if (tid < 16) rc4 = *(const f32x4*)(cb + kt * 64 + tid * 4); }
    };
    auto late_v = [&](int kt) {
        if (DV != 64) {
            const char* vp = (const char*)Vb + (size_t)kt * 128 * ldv;
#pragma unroll
            for (int i = 0; i < NVL; ++i) rv[i] = *(const u32x4*)(vp + vofs[i]);
        }
    };
    auto stash = [&](int buf) {
        LDS char* b = sm + buf * BUFSZ;
#pragma unroll
        for (int i = 0; i < 1; ++i) { const int idx = tid + NT * i, row = idx >> 3, c = idx & 7; *(LDS u32x4*)(b + row * 128 + ((c ^ ((row >> 1) & 7)) << 4)) = rk[i]; }
#pragma unroll
        for (int i = 0; i < NVL; ++i) { const int idx = tid + NT * i, row = idx / VCH, c = idx % VCH; *(LDS u32x4*)(b + 8192 + row * VSTR + c * 16) = rv[i]; }
        if (BIAS) { if (tid < 16) *(LDS f32x4*)(b + 8192 + 64 * VSTR + tid * 16) = rc4; }
    };
    prefetch(0); late_v(0); stash(0); __syncthreads();
    const int q4 = (lane & 15) >> 2, p4 = lane & 3, g1 = (lane >> 4) & 1;
    const int voff = (4 * hh + q4) * VSTR + (16 * g1 + 4 * p4) * 2;
    for (int kt = 0; kt < ntiles; ++kt) {
        if (kt + 1 < ntiles) prefetch(kt + 1);
        if (wactive && kt * 64 <= wkmax) {
            LDS char* kb = sm + (kt & 1) * BUFSZ; LDS char* vb = kb + 8192; LDS char* cbp = vb + 64 * VSTR;
            const bool need_mask = kt * 64 + 63 > wkmin;
#pragma unroll
            for (int st = 0; st < 2; ++st) {
                asm volatile("" ::: "memory");
                f32x16 S;
#pragma unroll
                for (int i = 0; i < 16; ++i) S[i] = 0.f;
#pragma unroll
                for (int ks = 0; ks < 4; ++ks) {
                    const bf16x8 a = *(LDS bf16x8*)(kb + (st * 32 + r) * 128 + ((((ks << 1) | hh) ^ ((r >> 1) & 7)) << 4));
                    S = MFMA(a, qf[ks], S);
                }
                if (BIAS) {
#pragma unroll
                    for (int g = 0; g < 4; ++g) {
                        const f32x4 c4 = *(LDS f32x4*)(cbp + (st * 32 + 8 * g + 4 * hh) * 4);
                        S[4 * g + 0] += c4.x; S[4 * g + 1] += c4.y; S[4 * g + 2] += c4.z; S[4 * g + 3] += c4.w;
                    }
                }
                if (need_mask) {
#pragma unroll
                    for (int i = 0; i < 16; ++i) { const int key = kt * 64 + st * 32 + crow(i, hh); if (key > klim) S[i] = -1e30f; }
                }
                float mx = S[0];
#pragma unroll
                for (int i = 1; i < 16; ++i) mx = fmaxf(mx, S[i]);
                mx = fmaxf(mx, __shfl_xor(mx, 32));
                if (__any(mx > m)) {
                    const float mn = fmaxf(m, mx);
                    const float alpha = __builtin_amdgcn_exp2f(m - mn);
                    m = mn; l *= alpha;
#pragma unroll
                    for (int dt = 0; dt < DV / 32; ++dt)
#pragma unroll
                        for (int i = 0; i < 16; ++i) O[dt][i] *= alpha;
                }
                float ps = 0.f;
#pragma unroll
                for (int i = 0; i < 16; ++i) { const float p = __builtin_amdgcn_exp2f(S[i] - m); S[i] = p; ps += p; }
                l += ps;
                bf16x8 pf[2];
#pragma unroll
                for (int s = 0; s < 2; ++s) {
                    const u32x4 w = {pk2(S[8 * s + 0], S[8 * s + 1]), pk2(S[8 * s + 2], S[8 * s + 3]), pk2(S[8 * s + 4], S[8 * s + 5]), pk2(S[8 * s + 6], S[8 * s + 7])};
                    pf[s] = __builtin_bit_cast(bf16x8, w);
                }
#pragma unroll
                for (int dt = 0; dt < DV / 32; ++dt) {
                    if (DV > 64) asm volatile("" ::: "memory");
#pragma unroll
                    for (int s = 0; s < 2; ++s) {
                        const s16x4 lo = __builtin_amdgcn_ds_read_tr16_b64_v4i16((LDS s16x4*)(vb + voff + (st * 32 + s * 16) * VSTR + dt * 64));
                        const s16x4 hi = __builtin_amdgcn_ds_read_tr16_b64_v4i16((LDS s16x4*)(vb + voff + (st * 32 + s * 16 + 8) * VSTR + dt * 64));
                        const bf16x8 a = __builtin_shufflevector(lo, hi, 0, 1, 2, 3, 4, 5, 6, 7);
                        O[dt] = MFMA(a, pf[s], O[dt]);
                    }
                }
            }
        }
        if (kt + 1 < ntiles) { late_v(kt + 1); stash((kt + 1) & 1); }
        __syncthreads();
    }
    l_out = l + __shfl_xor(l, 32);
}

DI int next_unit(unsigned* ctr) {
    LDS int* su = (LDS int*)((LDS char*)smem + 65528);
    if (TIDX == 0) *su = (int)atomicAdd(ctr, 1u);
    __syncthreads();
    const int u = *su;
    __syncthreads();
    return u;
}

DI int attn_unit(unsigned* ctr, int iter) {
    if (gridDim.x == 256) {
        if (iter < 4) {
            const int g = blockIdx.x >> 6, sh = blockIdx.x & 63;
            const int qb = (iter == 0) ? 15 - g : (iter == 1) ? 8 + g : (iter == 2) ? 7 - g : g;
            return 128 + (15 - qb) * 64 + sh;
        }
        const int u = next_unit(ctr);
        return u < 128 ? u : -1;
    }
    const int u = next_unit(ctr);
    return u < 128 + 1024 ? u : -1;
}

DI void unit_decode(int u, int& samp, int& s, int& h, int& qb) {
    if (u < 128) { samp = 1; s = u >> 3; h = u & 7; qb = 0; }
    else { const int v = u - 128; samp = 0; qb = 15 - (v >> 6); s = (v & 63) >> 3; h = v & 7; }
}

DI void phase_fox_attn(const Params& P, unsigned* ctr) {
    const bf16_t* QE = (const bf16_t*)(P.ws + R_QE);
    bf16_t* MIX = (bf16_t*)(P.ws + OFF_HN);
    const int lane = TIDX & 63, wave = TIDX >> 6, r = lane & 31, hh = lane >> 5;
    for (int iter = 0;; ++iter) {
        const int u = attn_unit(ctr, iter);
        if (u < 0) break;
        int samp, s, h, qb; unit_decode(u, samp, s, h, qb);
        const bf16_t *Qb, *Kb, *Vb; const float* cb; int nq, past, kvlen, row0;
        if (!samp) {
            row0 = s * 4096; nq = 4096; past = 0; kvlen = 4096;
            Kb = (const bf16_t*)(P.ws + R_KE) + (size_t)row0 * 512 + h * 64; Vb = (const bf16_t*)(P.ws + R_VE) + (size_t)row0 * 512 + h * 64;
            cb = (const float*)(P.ws + R_CBP) + (size_t)(s * 8 + h) * 4096;
        } else {
            row0 = MP + s * 16; nq = 16; past = 1024; kvlen = 1040;
            Kb = (const bf16_t*)(P.ws + OFF_KS) + (size_t)s * KVS * 512 + h * 64; Vb = (const bf16_t*)(P.ws + OFF_VS) + (size_t)s * KVS * 512 + h * 64;
            cb = (const float*)(P.ws + R_CBS) + (size_t)(s * 8 + h) * KVS;
        }
        Qb = QE + (size_t)row0 * 512 + h * 64;
        f32x16 O[2]; float l;
        flash_pass<64, true>(Qb, 512, Kb, 512, Vb, 512, cb, qb * 256, nq, past, 0, kvlen, O, l);
        const int qi = qb * 256 + wave * 32 + r;
        if (qi < nq) {
            const float inv = 1.0f / l;
            bf16_t* dst = MIX + (size_t)(row0 + qi) * 1024 + 512 + h * 64;
#pragma unroll
            for (int dt = 0; dt < 2; ++dt)
#pragma unroll
                for (int g = 0; g < 4; ++g)
                    *(u32x2*)(dst + dt * 32 + 8 * g + 4 * hh) = (u32x2){pk2(O[dt][4 * g] * inv, O[dt][4 * g + 1] * inv), pk2(O[dt][4 * g + 2] * inv, O[dt][4 * g + 3] * inv)};
        }
    }
}

DI void phase_diff_attn(const Params& P, int o, int layer, unsigned* ctr) {
    const bf16_t* QO = (const bf16_t*)(P.ws + R_QO);
    float* O1 = (float*)(P.ws + R_O1);
    bf16_t* MIX = (bf16_t*)(P.ws + OFF_HN);
    const int lane = TIDX & 63, wave = TIDX >> 6, r = lane & 31, hh = lane >> 5;
    const float lam_init = 0.8f - 0.6f * expf(-0.3f * (float)layer);
    const float* lp = P.in[I_DLAM] + o * 256;
    const float s1 = wave_sum(lp[lane] * lp[64 + lane]), s2 = wave_sum(lp[128 + lane] * lp[192 + lane]);
    const float lam = expf(s1) - expf(s2) + lam_init;
    const float* sg = P.in[I_SUBG] + o * 128;
    for (int iter = 0;; ++iter) {
        const int u = attn_unit(ctr, iter);
        if (u < 0) break;
        int samp, s, h, qb; unit_decode(u, samp, s, h, qb);
        const bf16_t *Kb, *Vb; int nq, past, kvlen, row0;
        if (!samp) {
            row0 = s * 4096; nq = 4096; past = 0; kvlen = 4096;
            Kb = (const bf16_t*)(P.ws + R_KO) + (size_t)row0 * 1024 + h * 128; Vb = (const bf16_t*)(P.ws + R_VO) + (size_t)row0 * 1024 + h * 128;
        } else {
            row0 = MP + s * 16; nq = 16; past = 1024; kvlen = 1040;
            Kb = (const bf16_t*)(P.ws + OFF_KS) + (size_t)s * KVS * 1024 + h * 128; Vb = (const bf16_t*)(P.ws + OFF_VS) + (size_t)s * KVS * 1024 + h * 128;
        }
        const bf16_t* Qb = QO + (size_t)row0 * 1024 + h * 128;
        const int qi = qb * 256 + wave * 32 + r;
        const unsigned rowc = (unsigned)(row0 + (qi < nq ? qi : nq - 1));
        const unsigned o1off = (rowc * 1024u + (unsigned)(h * 128 + 4 * hh)) * 4u;
        const unsigned mixoff = (rowc * 1024u + (unsigned)(h * 128 + 4 * hh)) * 2u;
        for (int c = 0; c < 2; ++c) {
            f32x16 O[4]; float l;
            flash_pass<128, false>(Qb + c * 64, 1024, Kb + c * 64, 1024, Vb, 1024, nullptr, qb * 256, nq, past, 1, kvlen, O, l);
            if (qi < nq) {
                const float inv = 1.0f / l;
                char* o1p = (char*)O1 + o1off;
                if (c == 0) {
#pragma unroll
                    for (int dt = 0; dt < 4; ++dt)
#pragma unroll
                        for (int g = 0; g < 4; ++g)
                            *(f32x4*)(o1p + (dt * 32 + 8 * g) * 4) = (f32x4){O[dt][4 * g] * inv, O[dt][4 * g + 1] * inv, O[dt][4 * g + 2] * inv, O[dt][4 * g + 3] * inv};
                } else {
                    float ss = 0.f;
                    const float nl = -lam * inv;
#pragma unroll
                    for (int dt = 0; dt < 4; ++dt)
#pragma unroll
                        for (int i = 0; i < 16; ++i) O[dt][i] *= nl;
#pragma unroll
                    for (int dt = 0; dt < 4; ++dt) {
#pragma unroll
                        for (int g = 0; g < 4; ++g) {
                            const f32x4 a = *(const f32x4*)(o1p + (dt * 32 + 8 * g) * 4);
#pragma unroll
                            for (int j = 0; j < 4; ++j) { const float v = a[j] + O[dt][4 * g + j]; O[dt][4 * g + j] = v; ss += v * v; }
                        }
                        asm volatile("" : "+v"(ss) :: "memory");
                    }
                    ss += __shfl_xor(ss, 32);
                    const float rstd = rsqrtf(ss * (1.0f / 128.0f) + EPSN) * (1.0f - lam_init);
                    char* dst = (char*)MIX + mixoff;
                    const char* sgp = (const char*)sg + hh * 16;
#pragma unroll
                    for (int dt = 0; dt < 4; ++dt) {
                        asm volatile("" ::: "memory");
#pragma unroll
                        for (int g = 0; g < 4; ++g) {
                            const f32x4 gg = *(const f32x4*)(sgp + (dt * 32 + 8 * g) * 4);
                            *(u32x2*)(dst + (dt * 32 + 8 * g) * 2) = (u32x2){pk2(O[dt][4 * g] * rstd * gg.x, O[dt][4 * g + 1] * rstd * gg.y), pk2(O[dt][4 * g + 2] * rstd * gg.z, O[dt][4 * g + 3] * rstd * gg.w)};
                        }
                        asm volatile("" ::: "memory");
                    }
                }
            }
        }
    }
}


#define XB_TMO      128
#define XB_XCNT(j)  (256  + 64 * (j))
#define XB_XSUB(j)  (1280 + 64 * (j))
#define XB_XGEN(j)  (2304 + 64 * (j))
#define XB_TOP      3328
#define XB_TOPGEN   3392
#define XCD_BAR_WORDS 3456
#define XB_SPIN_CAP (1u << 22)
DI unsigned xb_ld(unsigned* p) { return __hip_atomic_load(p, __ATOMIC_RELAXED, __HIP_MEMORY_SCOPE_AGENT); }
DI unsigned xb_add(unsigned* p, unsigned v) { return __hip_atomic_fetch_add(p, v, __ATOMIC_RELAXED, __HIP_MEMORY_SCOPE_AGENT); }
DI unsigned xb_xcc_id() { return (unsigned)__builtin_amdgcn_s_getreg((3 << 11) | 20) & 0xFu; }
#define XB_SPIN(cond, bar) do { unsigned _sp = 0; while (cond) { __builtin_amdgcn_s_sleep(1); \
    if ((++_sp & 255u) == 0u) { if (xb_ld(&(bar)[XB_TMO])) break; if (_sp > XB_SPIN_CAP) { atomicAdd(&(bar)[XB_TMO], 1u); break; } } } } while (0)
__shared__ __attribute__((aligned(16))) unsigned xb_words[4];
struct XcdBarrier { unsigned* bar; unsigned x; };
DI XcdBarrier xcd_barrier_post(unsigned* bar) {
    XcdBarrier b; b.bar = bar; b.x = xb_xcc_id();
    if (threadIdx.x == 0) (void)xb_add(&bar[XB_XCNT(b.x)], 1u);
    return b;
}
DI void xcd_barrier_complete(unsigned* bar, unsigned x, unsigned& nloc, unsigned& nx) {
    const unsigned G = gridDim.x * gridDim.y * gridDim.z;
    unsigned sum, cnt, mine, sp = 0u;
    for (;;) {
        sum = 0u; cnt = 0u; mine = 0u;
#pragma unroll
        for (unsigned j = 0; j < 16; ++j) { const unsigned c = xb_ld(&bar[XB_XCNT(j)]); sum += c; cnt += (c > 0u) ? 1u : 0u; mine = (j == x) ? c : mine; }
        if (sum == G) break;
        __builtin_amdgcn_s_sleep(1);
        if ((++sp & 255u) == 0u) { if (xb_ld(&bar[XB_TMO])) break; if (sp > XB_SPIN_CAP) { atomicAdd(&bar[XB_TMO], 1u); break; } }
    }
    nloc = mine > 0u ? mine : 1u; nx = cnt > 0u ? cnt : 1u;
}
DI void xcd_barrier(const XcdBarrier& b) {
    volatile LDS unsigned* st = (volatile LDS unsigned*)xb_words;
    asm volatile("s_waitcnt vmcnt(0)" ::: "memory");
    __syncthreads();
    if (threadIdx.x == 0) {
        unsigned* bar = b.bar;
        __builtin_amdgcn_s_waitcnt(0);
        unsigned nloc = st[0], nx = st[1];
        if (nloc == 0u) { xcd_barrier_complete(bar, b.x, nloc, nx); st[0] = nloc; st[1] = nx; }
        const unsigned old = xb_add(&bar[XB_XSUB(b.x)], 1u);
        const unsigned gen = old / nloc;
        if (old + 1u == (gen + 1u) * nloc) {
            __builtin_amdgcn_fence(__ATOMIC_RELEASE, "agent");
            asm volatile("s_waitcnt vmcnt(0)" ::: "memory");
            const unsigned og = xb_add(&bar[XB_TOP], 1u);
            const unsigned tg = og / nx;
            if (og + 1u == (tg + 1u) * nx) xb_add(&bar[XB_TOPGEN], 1u);
            else XB_SPIN(xb_ld(&bar[XB_TOPGEN]) == tg, bar);
            __builtin_amdgcn_fence(__ATOMIC_ACQUIRE, "agent");
            xb_add(&bar[XB_XGEN(b.x)], 1u);
            asm volatile("s_waitcnt vmcnt(0)" ::: "memory");
        } else {
            XB_SPIN(xb_ld(&bar[XB_XGEN(b.x)]) == gen, bar);
            __builtin_amdgcn_fence(__ATOMIC_ACQUIRE, "agent");
            asm volatile("s_waitcnt vmcnt(0)" ::: "memory");
        }
    }
    __syncthreads();
}

constexpr int NPHASE = 45;
DI void run_phase(const Params& P, int ph) {
    unsigned* ctrl = (unsigned*)(P.ws + OFF_CTRL);
    if (ph == 0) {
        phase_prologue(P);
        phase_norm(P, 0, 0.f, nullptr, P.in[I_NG]);
        return;
    }
    int q = ph - 1, l, st;
    if (q < 12) { l = 0; st = q; } else if (q < 22) { l = 1; st = q - 12; } else if (q < 34) { l = 2; st = q - 22; } else { l = 3; st = q - 34; }
    const bool even = (l & 1) == 0; const int li = l >> 1;
    const float* ng = P.in[I_NG] + (size_t)l * 6 * DM;
    const bf16_t* HN = (const bf16_t*)(P.ws + OFF_HN);
    bf16_t* OUT = (bf16_t*)(P.ws + OFF_OUT);
    bf16_t* ACT = (bf16_t*)(P.ws + R_ACT);
    const bf16_t* wfi = (const bf16_t*)(P.ws + OFF_WT_FFN_IN); const bf16_t* wfo = (const bf16_t*)(P.ws + OFF_WT_FFN_OUT);
    const int nst = even ? 12 : 10;
    if (st == 0 || st == nst - 3) {
        const int f = (st == 0) ? 0 : 1;
        GemmArgs g{HN, DM, 0, wfi + (size_t)(l * 2 + f) * 5632 * 1024, 1024, 128, 22, 88, 0};
        gemm_phase<EPI_SWIGLU>(P, 0, g, ACT, DFF);
    } else if (st == 1 || st == nst - 2) {
        const int f = (st == 1) ? 0 : 1;
        GemmArgs g{ACT, DFF, 0, wfo + (size_t)(l * 2 + f) * 1024 * DFF, DFF, 128, 4, 176, 1};
        gemm_phase<EPI_PLAIN>(P, 0, g, OUT, DM);
    } else if (st == 2) {
        phase_norm(P, 1, 0.5f, ng + 1 * DM, ng + 2 * DM);
        if (even) cache_prep(P.in[I_CFK] + (size_t)li * 16 * 1024 * 512, P.in[I_CFV] + (size_t)li * 16 * 1024 * 512, (bf16_t*)(P.ws + OFF_KS), (bf16_t*)(P.ws + OFF_VS), 512);
        else cache_prep(P.in[I_CDK] + (size_t)li * 16 * 1024 * 1024, P.in[I_CDV] + (size_t)li * 16 * 1024 * 1024, (bf16_t*)(P.ws + OFF_KS), (bf16_t*)(P.ws + OFF_VS), 1024);
    } else if (st == nst - 1) {
        phase_norm(P, 1, 0.5f, ng + 5 * DM, (l < 3) ? ng + 6 * DM : nullptr);
    } else if (st == nst - 4) {
        phase_norm(P, 1, 1.0f, ng + 3 * DM, ng + 4 * DM);
    } else if (st == nst - 5) {
        const bf16_t* wo = even ? (const bf16_t*)(P.ws + OFF_WT_OUT_EVEN) : (const bf16_t*)(P.ws + OFF_WT_OUT_ODD);
        GemmArgs g{HN, DM, 0, wo + (size_t)li * 1024 * 1024, 1024, 128, 4, 64, 1};
        gemm_phase<EPI_PLAIN>(P, 0, g, OUT, DM);
    } else if (even) {
        if (st == 3) {
            GemmArgs g{HN, DM, 0, (const bf16_t*)(P.ws + OFF_WT_IN_EVEN) + (size_t)li * 2816 * 1024, 1024, 129, 11, 0, 0};
            gemm_phase<EPI_EVEN_IN>(P, li, g, nullptr, 0);
        } else if (st == 4) {
            phase_conv(P, li);
        } else if (st == 5) {
            GemmArgs g{(const bf16_t*)(P.ws + R_UC), 512, 128, (const bf16_t*)(P.ws + OFF_WT_GATES) + (size_t)li * 4 * 256 * 128, 128, 129, 4, 0, 0};
            gemm_phase<EPI_GATES>(P, li, g, nullptr, 0);
        } else if (st == 6) {
            phase_scan3(P, li);
            phase_fox_attn(P, ctrl + 16 * l);
        }
    } else {
        if (st == 3) {
            GemmArgs g{HN, DM, 0, (const bf16_t*)(P.ws + OFF_WT_IN_ODD) + (size_t)li * 3072 * 1024, 1024, 129, 12, 0, 0};
            gemm_phase<EPI_ODD_IN>(P, li, g, nullptr, 0);
        } else if (st == 4) {
            phase_diff_attn(P, li, l, ctrl + 16 * l);
        }
    }
}

#if MULTI_LAUNCH
__global__ void __launch_bounds__(512, 2) phase_kernel(Params P, int ph) { run_phase(P, ph); }
#else
__global__ void __launch_bounds__(512, 2) mega_kernel(Params P) {
    cg::grid_group grid = cg::this_grid();
    if (threadIdx.x < 4) xb_words[threadIdx.x] = 0u;
    __syncthreads();
    const XcdBarrier xb = xcd_barrier_post((unsigned*)(P.ws + OFF_BAR));
    for (int ph = 0; ph < NPHASE; ++ph) {
        run_phase(P, ph);
        if (ph == 0) grid.sync();
        else if (ph + 1 < NPHASE) xcd_barrier(xb);
    }
}
#endif

extern "C" void kernel_launch(void* const* d_in, const int* in_sizes, int n_in, void* d_out, int out_size, void* d_ws, size_t ws_size,
                              hipStream_t stream) {
    Params p{};
    for (int i = 0; i < 24; ++i) p.in[i] = (const float*)d_in[i];
    p.out = (float*)d_out; p.ws = (char*)d_ws;
    if (ws_size < WS_NEEDED) fprintf(stderr, "workspace too small: %zu < %zu\n", ws_size, (size_t)WS_NEEDED);
    hipMemsetAsync(d_ws, 0, 20480, stream);
    static int grid_blocks = 0;
    if (!grid_blocks) {
        int dev = 0, cus = 0, per_cu = 0;
        hipGetDevice(&dev);
        hipDeviceGetAttribute(&cus, hipDeviceAttributeMultiprocessorCount, dev);
#if MULTI_LAUNCH
        hipOccupancyMaxActiveBlocksPerMultiprocessor(&per_cu, phase_kernel, NT, 0);
#else
        hipOccupancyMaxActiveBlocksPerMultiprocessor(&per_cu, mega_kernel, NT, 0);
#endif
        if (per_cu < 1) per_cu = 1;
        if (per_cu > 1) per_cu = 1;
        grid_blocks = cus * per_cu;
    }
#if MULTI_LAUNCH
    for (int ph = 0; ph < NPHASE; ++ph) phase_kernel<<<grid_blocks, NT, 0, stream>>>(p, ph);
#else
    void* args[] = {&p};
    hipError_t e = hipLaunchCooperativeKernel((void*)mega_kernel, dim3(grid_blocks), dim3(NT), args, 0, stream);
    if (e != hipSuccess) fprintf(stderr, "cooperative launch failed: %s (grid %d)\n", hipGetErrorString(e), grid_blocks);
#endif
}
```

```cpp
#include <hip/hip_runtime.h>
#include <hip/hip_cooperative_groups.h>
#include <cstdio>
#include <cstdint>
namespace cg = cooperative_groups;

#ifndef MULTI_LAUNCH
#define MULTI_LAUNCH 0
#endif

#define DI __device__ __forceinline__
#define LDS __attribute__((address_space(3)))
typedef unsigned short bf16_t;
typedef short bf16x8 __attribute__((ext_vector_type(8)));
typedef short s16x4 __attribute__((ext_vector_type(4)));
typedef float f32x16 __attribute__((ext_vector_type(16)));
typedef float f32x4 __attribute__((ext_vector_type(4)));
typedef float f32x2 __attribute__((ext_vector_type(2)));
typedef unsigned u32x4 __attribute__((ext_vector_type(4)));
typedef unsigned u32x2 __attribute__((ext_vector_type(2)));
typedef __bf16 bf2_t __attribute__((ext_vector_type(2)));
#define MFMA(a, b, c) __builtin_amdgcn_mfma_f32_32x32x16_bf16((a), (b), (c), 0, 0, 0)

constexpr int MP = 32768, MS = 256, MT = 33024;
constexpr int DM = 1024, DFF = 2816;
constexpr float LOG2E = 1.4426950408889634f;
constexpr float EPSN = 1e-6f;
constexpr int NT = 512, NW = 8;
constexpr int KVS = 1088;

constexpr size_t OFF_CTRL = 0;
constexpr size_t OFF_BAR = 4096;
constexpr size_t OFF_ROPE = 20480;
constexpr size_t OFF_WT_FFN_IN = OFF_ROPE + 262144;
constexpr size_t OFF_WT_FFN_OUT = OFF_WT_FFN_IN + 92274688;
constexpr size_t OFF_WT_IN_EVEN = OFF_WT_FFN_OUT + 46137344;
constexpr size_t OFF_WT_OUT_EVEN = OFF_WT_IN_EVEN + 11534336;
constexpr size_t OFF_WT_IN_ODD = OFF_WT_OUT_EVEN + 4194304;
constexpr size_t OFF_WT_OUT_ODD = OFF_WT_IN_ODD + 12582912;
constexpr size_t OFF_WT_GATES = OFF_WT_OUT_ODD + 4194304;
constexpr size_t OFF_SACC = OFF_WT_GATES + 524288;
constexpr size_t OFF_HN = OFF_SACC + 1048576;
constexpr size_t OFF_OUT = OFF_HN + 67633152;
constexpr size_t OFF_KS = OFF_OUT + 67633152;
constexpr size_t OFF_VS = OFF_KS + 35651584;
constexpr size_t OFF_R = OFF_VS + 35651584;
constexpr size_t R_ACT = OFF_R;
constexpr size_t R_U = OFF_R;
constexpr size_t R_G = R_U + 67633152;
constexpr size_t R_QE = R_G + 33816576;
constexpr size_t R_KE = R_QE + 33816576;
constexpr size_t R_VE = R_KE + 33554432;
constexpr size_t R_LOGF = R_VE + 33554432;
constexpr size_t R_CBP = R_LOGF + 1056768;
constexpr size_t R_CBS = R_CBP + 1048576;
constexpr size_t R_UC = R_CBS + 557056;
constexpr size_t R_LA = R_UC + 33816576;
constexpr size_t R_IU = R_LA + 67633152;
constexpr size_t R_SEGA = R_IU + 67633152;
constexpr size_t R_SEGB = R_SEGA + 1081344;
constexpr size_t R_EVEN_END = R_SEGB + 1081344;
constexpr size_t R_QO = OFF_R;
constexpr size_t R_KO = R_QO + 67633152;
constexpr size_t R_VO = R_KO + 67108864;
constexpr size_t R_O1 = R_VO + 67108864;
constexpr size_t R_ODD_END = R_O1 + 135266304;
constexpr size_t WS_NEEDED = (R_EVEN_END > R_ODD_END ? R_EVEN_END : R_ODD_END);

constexpr size_t O_Y = 0;
constexpr size_t O_PFK = O_Y + (size_t)MT * 1024;
constexpr size_t O_PFV = O_PFK + 33554432;
constexpr size_t O_PFL = O_PFV + 33554432;
constexpr size_t O_PLH = O_PFL + 524288;
constexpr size_t O_PLC = O_PLH + 8192;
constexpr size_t O_PDK = O_PLC + 24576;
constexpr size_t O_PDV = O_PDK + 67108864;
constexpr size_t O_SFK = O_PDV + 67108864;
constexpr size_t O_SFV = O_SFK + 262144;
constexpr size_t O_SFL = O_SFV + 262144;
constexpr size_t O_SLH = O_SFL + 4096;
constexpr size_t O_SLC = O_SLH + 16384;
constexpr size_t O_SDK = O_SLC + 49152;
constexpr size_t O_SDV = O_SDK + 524288;

enum { I_XP = 0, I_XS, I_CFK, I_CFV, I_CFL, I_SLH, I_SLC, I_CDK, I_CDV, I_NG, I_WFI, I_WFO, I_WIE, I_BFF, I_CW, I_CB, I_WG, I_BG,
       I_LAM, I_WOE, I_WIO, I_DLAM, I_SUBG, I_WOO };

struct Params {
    const float* in[24];
    float* out;
    char* ws;
};

__shared__ __attribute__((aligned(16))) char smem[131072];

DI int tid_opaque() { int t = threadIdx.x; asm volatile("" : "+v"(t)); return t; }
#define TIDX tid_opaque()
DI float bf2f(bf16_t x) { return __uint_as_float(((unsigned)x) << 16); }
DI unsigned pk2(float lo, float hi) { f32x2 v = {lo, hi}; bf2_t b = __builtin_convertvector(v, bf2_t); return __builtin_bit_cast(unsigned, b); }
DI bf16_t f2bf(float x) { return (bf16_t)(pk2(x, 0.f) & 0xffffu); }
DI float wave_sum(float v) {
#pragma unroll
    for (int o = 32; o >= 1; o >>= 1) v += __shfl_xor(v, o);
    return v;
}
DI float sigmoidf_(float x) { return 1.0f / (1.0f + __expf(-x)); }
DI float softplusf_(float x) { return fmaxf(x, 0.f) + log1pf(__expf(-fabsf(x))); }
DI float gelu_tanh(float x) { const float u = 0.7978845608028654f * (x + 0.044715f * x * x * x); return x / (1.0f + __expf(-2.0f * u)); }
DI int crow(int i, int hh) { return (i & 3) + 8 * (i >> 2) + 4 * hh; }

struct WtJob { const float* src; bf16_t* dst; int K, Ns, mode, p0, k0; };
DI WtJob wt_decode(const Params& P, int t) {
    int tt = t, g;
    if (tt < 11264) g = 0; else if ((tt -= 11264) < 5632) g = 1; else if ((tt -= 5632) < 1408) g = 2; else if ((tt -= 1408) < 512) g = 3;
    else if ((tt -= 512) < 1536) g = 4; else { tt -= 1536; g = 5; }
    const float* src; bf16_t* dst; int K = 1024, Ns = 1024, Nd = 1024, mode = 0;
    switch (g) {
        case 0: src = P.in[I_WFI]; dst = (bf16_t*)(P.ws + OFF_WT_FFN_IN); mode = 1; Ns = 5632; Nd = 5632; break;
        case 1: src = P.in[I_WFO]; dst = (bf16_t*)(P.ws + OFF_WT_FFN_OUT); K = 2816; break;
        case 2: src = P.in[I_WIE]; dst = (bf16_t*)(P.ws + OFF_WT_IN_EVEN); Ns = 2568; Nd = 2816; break;
        case 3: src = P.in[I_WOE]; dst = (bf16_t*)(P.ws + OFF_WT_OUT_EVEN); break;
        case 4: src = P.in[I_WIO]; dst = (bf16_t*)(P.ws + OFF_WT_IN_ODD); Ns = 3072; Nd = 3072; break;
        default: src = P.in[I_WOO]; dst = (bf16_t*)(P.ws + OFF_WT_OUT_ODD); break;
    }
    const int npt = Nd / 64, tpm = npt * (K / 64);
    const int mat = tt / tpm, ti = tt % tpm;
    WtJob j; j.src = src + (size_t)mat * K * Ns; j.dst = dst + (size_t)mat * Nd * K; j.K = K; j.Ns = Ns; j.mode = mode; j.p0 = (ti % npt) * 64; j.k0 = (ti / npt) * 64;
    return j;
}
DI void wt_load(const WtJob& j, float (&v)[8]) {
    const int tid = TIDX;
#pragma unroll
    for (int q = 0; q < 8; ++q) {
        const int idx = tid + NT * q, kk = idx >> 6, pp = idx & 63, p = j.p0 + pp;
        int col = p;
        if (j.mode == 1) { const int pn = p >> 8, w = p & 255; col = ((w >> 5) & 1) * DFF + pn * 128 + (w >> 6) * 32 + (w & 31); }
        v[q] = (col < j.Ns) ? j.src[(size_t)(j.k0 + kk) * j.Ns + col] : 0.f;
    }
}
DI void wt_store(const WtJob& j, const float (&v)[8]) {
    float* T = (float*)smem;
    const int tid = TIDX;
#pragma unroll
    for (int q = 0; q < 8; ++q) { const int idx = tid + NT * q; T[(idx >> 6) * 65 + (idx & 63)] = v[q]; }
    __syncthreads();
    {
        const int pp = tid >> 3, ks = (tid & 7) * 8;
        unsigned w[4];
#pragma unroll
        for (int q = 0; q < 4; ++q) w[q] = pk2(T[(ks + 2 * q) * 65 + pp], T[(ks + 2 * q + 1) * 65 + pp]);
        *(u32x4*)(j.dst + (size_t)(j.p0 + pp) * j.K + j.k0 + ks) = (u32x4){w[0], w[1], w[2], w[3]};
    }
    __syncthreads();
}

DI void phase_prologue(const Params& P) {
    const int total = 20864;
    {
        int t = blockIdx.x;
        WtJob job{}; float cur[8];
        if (t < total) { job = wt_decode(P, t); wt_load(job, cur); }
        for (; t < total; t += gridDim.x) {
            const int tn = t + gridDim.x;
            WtJob jobn = job; float nxt[8];
            if (tn < total) { jobn = wt_decode(P, tn); wt_load(jobn, nxt); }
            else {
#pragma unroll
                for (int q = 0; q < 8; ++q) nxt[q] = 0.f;
            }
            wt_store(job, cur);
            job = jobn;
#pragma unroll
            for (int q = 0; q < 8; ++q) cur[q] = nxt[q];
        }
    }
    {
        bf16_t* wgx = (bf16_t*)(P.ws + OFF_WT_GATES);
        const float* wg = P.in[I_WG];
        for (int idx = blockIdx.x * NT + TIDX; idx < 2 * 4 * 256 * 128; idx += gridDim.x * NT) {
            const int k = idx & 127, n = (idx >> 7) & 255, pr = (idx >> 15) & 3, e = idx >> 17;
            float v = 0.f;
            if (n < 128) { if (k < 64) v = wg[((size_t)(e * 8 + 2 * pr) * 64 + k) * 128 + n]; }
            else { if (k >= 64) v = wg[((size_t)(e * 8 + 2 * pr + 1) * 64 + (k - 64)) * 128 + (n - 128)]; }
            wgx[idx] = f2bf(v);
        }
        float* sacc = (float*)(P.ws + OFF_SACC);
        for (int idx = blockIdx.x * NT + TIDX; idx < 256 * 1024; idx += gridDim.x * NT) sacc[idx] = 0.f;
    }
    {
        float* rc = (float*)(P.ws + OFF_ROPE); float* rs = rc + 32768;
        for (int idx = blockIdx.x * NT + TIDX; idx < 32768; idx += gridDim.x * NT) {
            const int pos = idx >> 3, i = idx & 7;
            const float inv = powf(500000.0f, -0.125f * (float)i);
            const float ang = (float)pos * inv;
            const double x = (double)ang;
            const double k = rint(x * 0.15915494309189535);
            const float rr = (float)(x - k * 6.283185307179586);
            rc[idx] = __cosf(rr); rs[idx] = __sinf(rr);
        }
    }
}

DI void phase_norm(const Params& P, int mode, float scale, const float* __restrict__ g_post, const float* __restrict__ g_next) {
    const int lane = TIDX & 63, wave = TIDX >> 6;
    float* X = P.out + O_Y;
    bf16_t* HN = (bf16_t*)(P.ws + OFF_HN);
    const bf16_t* OUT = (const bf16_t*)(P.ws + OFF_OUT);
    for (int row = blockIdx.x * NW + wave; row < MT; row += gridDim.x * NW) {
        f32x4 xv[4];
        if (mode == 0) {
            const float* src = row < MP ? P.in[I_XP] + (size_t)row * DM : P.in[I_XS] + (size_t)(row - MP) * DM;
#pragma unroll
            for (int i = 0; i < 4; ++i) xv[i] = *(const f32x4*)(src + lane * 4 + 256 * i);
        } else {
            f32x4 ov[4], xo[4]; float ss = 0.f;
#pragma unroll
            for (int i = 0; i < 4; ++i) xo[i] = *(const f32x4*)(X + (size_t)row * DM + lane * 4 + 256 * i);
#pragma unroll
            for (int i = 0; i < 4; ++i) {
                if (row < MP) {
                    const u32x2 w = *(const u32x2*)(OUT + (size_t)row * DM + lane * 4 + 256 * i);
                    ov[i] = (f32x4){__uint_as_float(w.x << 16), __uint_as_float(w.x & 0xffff0000u), __uint_as_float(w.y << 16), __uint_as_float(w.y & 0xffff0000u)};
                } else {
                    float* sp = (float*)(P.ws + OFF_SACC) + (size_t)(row - MP) * DM + lane * 4 + 256 * i;
                    ov[i] = *(const f32x4*)sp;
                    *(f32x4*)sp = (f32x4){0.f, 0.f, 0.f, 0.f};
                }
                ss += ov[i].x * ov[i].x + ov[i].y * ov[i].y + ov[i].z * ov[i].z + ov[i].w * ov[i].w;
            }
            ss = wave_sum(ss);
            const float rstd = rsqrtf(ss * (1.0f / 1024.0f) + EPSN) * scale;
#pragma unroll
            for (int i = 0; i < 4; ++i) {
                const f32x4 gp = *(const f32x4*)(g_post + lane * 4 + 256 * i);
                xv[i] = xo[i] + ov[i] * rstd * gp;
            }
        }
#pragma unroll
        for (int i = 0; i < 4; ++i) *(f32x4*)(X + (size_t)row * DM + lane * 4 + 256 * i) = xv[i];
        if (g_next) {
            float ss = 0.f;
#pragma unroll
            for (int i = 0; i < 4; ++i) ss += xv[i].x * xv[i].x + xv[i].y * xv[i].y + xv[i].z * xv[i].z + xv[i].w * xv[i].w;
            ss = wave_sum(ss);
            const float rstd = rsqrtf(ss * (1.0f / 1024.0f) + EPSN);
#pragma unroll
            for (int i = 0; i < 4; ++i) {
                const f32x4 gn = *(const f32x4*)(g_next + lane * 4 + 256 * i);
                const f32x4 hv = xv[i] * rstd * gn;
                *(u32x2*)(HN + (size_t)row * DM + lane * 4 + 256 * i) = (u32x2){pk2(hv.x, hv.y), pk2(hv.z, hv.w)};
            }
        }
    }
}

DI void cache_prep(const float* __restrict__ ck, const float* __restrict__ cv, bf16_t* __restrict__ KS, bf16_t* __restrict__ VS_, int W) {
    const int cpr = W / 8;
    const int nch = 16 * 1024 * cpr;
    const int gsz = gridDim.x * NT;
    for (int idx0 = blockIdx.x * NT + TIDX; idx0 < 2 * nch; idx0 += 4 * gsz) {
        f32x4 a[4], bb[4]; bf16_t* d[4]; bool ok[4];
#pragma unroll
        for (int u = 0; u < 4; ++u) {
            const int idx = idx0 + u * gsz; ok[u] = idx < 2 * nch;
            const int idc = ok[u] ? idx : idx0;
            const int which = idc >= nch; const int id = which ? idc - nch : idc;
            const int c = id % cpr, rowg = id / cpr, b = rowg >> 10, k = rowg & 1023;
            const float* sp = (which ? cv : ck) + (size_t)rowg * W + c * 8;
            a[u] = *(const f32x4*)sp; bb[u] = *(const f32x4*)(sp + 4);
            d[u] = (which ? VS_ : KS) + ((size_t)(b * KVS + k)) * W + c * 8;
        }
#pragma unroll
        for (int u = 0; u < 4; ++u)
            if (ok[u]) *(u32x4*)d[u] = (u32x4){pk2(a[u].x, a[u].y), pk2(a[u].z, a[u].w), pk2(bb[u].x, bb[u].y), pk2(bb[u].z, bb[u].w)};
    }
    const int nz = 16 * 48 * cpr;
    for (int idx = blockIdx.x * NT + TIDX; idx < 2 * nz; idx += gridDim.x * NT) {
        const int which = idx >= nz; const int id = which ? idx - nz : idx;
        const int c = id % cpr, rowg = id / cpr, b = rowg / 48, k = 1040 + rowg % 48;
        bf16_t* d = (which ? VS_ : KS) + ((size_t)(b * KVS + k)) * W + c * 8;
        *(u32x4*)d = (u32x4){0u, 0u, 0u, 0u};
    }
}

struct GemmArgs { const bf16_t* A; int lda; int a_pn_stride; const bf16_t* Bt; int K; int nM, nN; int nsk, skc; };
enum { EPI_PLAIN = 0, EPI_SWIGLU, EPI_EVEN_IN, EPI_GATES, EPI_ODD_IN, EPI_SACC };

DI bool gemm_next(int it, int nM, int nN, int& pm, int& pn) {
    const int G = gridDim.x;
    if ((G & 7) == 0) {
        const int x = blockIdx.x & 7, bl = blockIdx.x >> 3, bpx = G >> 3, j = bl + it * bpx;
        const int nMx = (nM - x + 7) >> 3;
        if (j >= nMx * nN) return false;
        const int grp = j / (8 * nN), within = j % (8 * nN);
        int gsz = nMx - grp * 8; if (gsz > 8) gsz = 8;
        pn = within / gsz; pm = x + 8 * (grp * 8 + within % gsz);
        return true;
    } else {
        const int t = blockIdx.x + it * G;
        if (t >= nM * nN) return false;
        pm = t / nN; pn = t % nN; return true;
    }
}

template <int EPI, bool QUARTER = false>
DI void gemm_epilogue(const Params& P, int li, const f32x16 (&acc)[4][2], int pm, int pn, bf16_t* __restrict__ C, int ldc, int q = 0) {
    const int tid = TIDX, lane = tid & 63, wave = tid >> 6, wr = wave >> 2, wc = QUARTER ? q : (wave & 3), r = lane & 31, hh = lane >> 5;
    const int m0 = QUARTER ? pm * 256 + wave * 32 : pm * 256 + wr * 128;
    constexpr int NMT = QUARTER ? 1 : 4;
    const bool samp = pm * 256 >= MP;
    if (EPI == EPI_PLAIN) {
#pragma unroll
        for (int mt = 0; mt < 4; ++mt)
#pragma unroll
            for (int i = 0; i < 16; ++i) {
                const int row = m0 + mt * 32 + crow(i, hh);
#pragma unroll
                for (int nt = 0; nt < 2; ++nt) C[(size_t)row * ldc + pn * 256 + wc * 64 + nt * 32 + r] = f2bf(acc[mt][nt][i]);
            }
    } else if (EPI == EPI_SACC) {
        float* S = (float*)(P.ws + OFF_SACC);
#pragma unroll
        for (int mt = 0; mt < 4; ++mt)
#pragma unroll
            for (int i = 0; i < 16; ++i) {
                const int row = wr * 128 + mt * 32 + crow(i, hh);
#pragma unroll
                for (int nt = 0; nt < 2; ++nt) atomicAdd(S + (size_t)row * DM + pn * 256 + wc * 64 + nt * 32 + r, acc[mt][nt][i]);
            }
    } else if (EPI == EPI_SWIGLU) {
        const int j = pn * 128 + wc * 32 + r;
#pragma unroll
        for (int mt = 0; mt < 4; ++mt)
#pragma unroll
            for (int i = 0; i < 16; ++i) {
                const int row = m0 + mt * 32 + crow(i, hh);
                const float g = acc[mt][0][i], u = acc[mt][1][i];
                C[(size_t)row * DFF + j] = f2bf(g / (1.0f + __expf(-g)) * u);
            }
    } else if (EPI == EPI_EVEN_IN) {
        const int e = li;
        const int sec = (pn * 256) >> 9;
        const int cb0 = ((pn * 256) & 511) + wc * 64 + r;
        if (sec == 0) {
            float* U = (float*)(P.ws + R_U);
#pragma unroll
            for (int mt = 0; mt < 4; ++mt)
#pragma unroll
                for (int i = 0; i < 16; ++i) {
                    const int row = m0 + mt * 32 + crow(i, hh);
#pragma unroll
                    for (int nt = 0; nt < 2; ++nt) U[(size_t)row * 512 + cb0 + nt * 32] = acc[mt][nt][i];
                }
        } else if (sec == 1) {
            bf16_t* Gb = (bf16_t*)(P.ws + R_G);
#pragma unroll
            for (int mt = 0; mt < 4; ++mt)
#pragma unroll
                for (int i = 0; i < 16; ++i) {
                    const int row = m0 + mt * 32 + crow(i, hh);
#pragma unroll
                    for (int nt = 0; nt < 2; ++nt) Gb[(size_t)row * 512 + cb0 + nt * 32] = f2bf(gelu_tanh(acc[mt][nt][i]));
                }
        } else if (sec == 2) {
            bf16_t* QE = (bf16_t*)(P.ws + R_QE);
#pragma unroll
            for (int mt = 0; mt < 4; ++mt)
#pragma unroll
                for (int i = 0; i < 16; ++i) {
                    const int row = m0 + mt * 32 + crow(i, hh);
#pragma unroll
                    for (int nt = 0; nt < 2; ++nt) QE[(size_t)row * 512 + cb0 + nt * 32] = f2bf(acc[mt][nt][i] * (0.125f * LOG2E));
                }
        } else if (sec == 3 || sec == 4) {
            bf16_t* bb; float* ob;
            if (!samp) { bb = (bf16_t*)(P.ws + (sec == 3 ? R_KE : R_VE)); ob = P.out + (sec == 3 ? O_PFK : O_PFV) + (size_t)e * (8 * 4096 * 512); }
            else { bb = (bf16_t*)(P.ws + (sec == 3 ? OFF_KS : OFF_VS)); ob = P.out + (sec == 3 ? O_SFK : O_SFV) + (size_t)e * (16 * 16 * 512); }
#pragma unroll
            for (int mt = 0; mt < 4; ++mt)
#pragma unroll
                for (int i = 0; i < 16; ++i) {
                    const int row = m0 + mt * 32 + crow(i, hh);
                    const int mm = row - MP;
                    const size_t rb = samp ? (size_t)((mm >> 4) * KVS + 1024 + (mm & 15)) : (size_t)row;
                    const size_t ro = samp ? (size_t)mm : (size_t)row;
#pragma unroll
                    for (int nt = 0; nt < 2; ++nt) {
                        const float v = acc[mt][nt][i];
                        bb[rb * 512 + cb0 + nt * 32] = f2bf(v);
                        ob[ro * 512 + cb0 + nt * 32] = v;
                    }
                }
        } else {
            float* LF = (float*)(P.ws + R_LOGF);
            if (cb0 < 8) {
                const float bf_ = P.in[I_BFF][e * 8 + cb0];
#pragma unroll
                for (int mt = 0; mt < 4; ++mt)
#pragma unroll
                    for (int i = 0; i < 16; ++i) {
                        const int row = m0 + mt * 32 + crow(i, hh);
                        const int mm = row - MP;
                        const float lf = -softplusf_(-(acc[mt][0][i] + bf_));
                        LF[(size_t)row * 8 + cb0] = lf;
                        if (!samp) P.out[O_PFL + (size_t)e * (8 * 4096 * 8) + (size_t)row * 8 + cb0] = lf;
                        else P.out[O_SFL + (size_t)e * (16 * 16 * 8) + (size_t)mm * 8 + cb0] = lf;
                    }
            }
        }
    } else if (EPI == EPI_GATES) {
        const int e = li, blk = 2 * pn + (wc >> 1);
        float* LA = (float*)(P.ws + R_LA); float* IU = (float*)(P.ws + R_IU); const bf16_t* UC = (const bf16_t*)(P.ws + R_UC);
#pragma unroll
        for (int nt = 0; nt < 2; ++nt) {
            const int n = (wc & 1) * 64 + nt * 32 + r, ch = blk * 64 + (n & 63);
            const float bias = P.in[I_BG][(e * 8 + blk) * 128 + n];
            const float sp = softplusf_(-P.in[I_LAM][e * 512 + ch]);
#pragma unroll
            for (int mt = 0; mt < 4; ++mt)
#pragma unroll
                for (int i = 0; i < 16; ++i) {
                    const int row = m0 + mt * 32 + crow(i, hh);
                    const float sg = sigmoidf_(acc[mt][nt][i] + bias);
                    if ((wc & 1) == 0) LA[(size_t)row * 512 + ch] = -8.0f * sg * sp;
                    else IU[(size_t)row * 512 + ch] = sg * bf2f(UC[(size_t)row * 512 + ch]);
                }
        }
    } else if (EPI == EPI_ODD_IN) {
        const int o = li;
        const int sec = (pn * 256) >> 10;
        bf16_t* QO = (bf16_t*)(P.ws + R_QO); bf16_t* KO = (bf16_t*)(P.ws + R_KO); bf16_t* VO = (bf16_t*)(P.ws + R_VO);
        bf16_t* KSb = (bf16_t*)(P.ws + OFF_KS); bf16_t* VSb = (bf16_t*)(P.ws + OFF_VS);
        const float* rc = (const float*)(P.ws + OFF_ROPE); const float* rs = rc + 32768;
#pragma unroll
        for (int mt = 0; mt < NMT; ++mt)
#pragma unroll
            for (int i = 0; i < 16; ++i) {
                const int row = m0 + mt * 32 + crow(i, hh);
                const int mm = row - MP;
                const int pos = samp ? 1024 + (mm & 15) : (row & 4095);
#pragma unroll
                for (int nt = 0; nt < 2; ++nt) {
                    const int c = ((pn * 256) & 1023) + wc * 64 + nt * 32 + r;
                    float v = acc[mt][nt][i];
                    if (sec < 2 && nt == 0) {
                        const float other = __shfl_xor(v, 8);
                        const float cs = rc[pos * 8 + (r & 7)], sn = rs[pos * 8 + (r & 7)];
                        if (r < 8) v = v * cs - other * sn;
                        else if (r < 16) v = v * cs + other * sn;
                    }
                    if (sec == 0) QO[(size_t)row * 1024 + c] = f2bf(v * (0.125f * LOG2E));
                    else {
                        bf16_t* dstb; float* dsto;
                        if (!samp) {
                            dstb = (sec == 1 ? KO : VO) + (size_t)row * 1024 + c;
                            dsto = P.out + (sec == 1 ? O_PDK : O_PDV) + (size_t)o * (8 * 4096 * 1024) + (size_t)row * 1024 + c;
                        } else {
                            dstb = (sec == 1 ? KSb : VSb) + ((size_t)((mm >> 4) * KVS + 1024 + (mm & 15))) * 1024 + c;
                            dsto = P.out + (sec == 1 ? O_SDK : O_SDV) + (size_t)o * (16 * 16 * 1024) + (size_t)mm * 1024 + c;
                        }
                        *dstb = f2bf(v); *dsto = v;
                    }
                }
            }
    }
}

template <bool QUARTER>
DI void gemm_tile_loop(const bf16_t* __restrict__ Ap, int lda, const bf16_t* __restrict__ Bp, int ldb, int ks0, int nks, f32x16 (&acc)[4][2], int q = 0) {
    const int tid = TIDX, lane = tid & 63, wave = tid >> 6, wr = wave >> 2, wc = wave & 3, r = lane & 31, hh = lane >> 5;
    const int sc = tid & 7, sr = tid >> 3;
    LDS char* sm = (LDS char*)smem;
#pragma unroll
    for (int a = 0; a < 4; ++a)
#pragma unroll
        for (int b = 0; b < 2; ++b)
#pragma unroll
            for (int i = 0; i < 16; ++i) acc[a][b][i] = 0.f;
    const unsigned aoff = (unsigned)(sr * lda + sc * 8) * 2u, astep = (unsigned)(64 * lda) * 2u;
    const unsigned boff = (unsigned)(sr * ldb + sc * 8) * 2u, bstep = (unsigned)(64 * ldb) * 2u;
    const int soff = sr * 128 + ((sc ^ ((sr >> 1) & 7)) << 4);
    const char* ap = (const char*)Ap + (size_t)ks0 * 128;
    const char* bp = (const char*)Bp + (size_t)ks0 * 128;
    u32x4 r0a[4], r0b[4], r1a[4], r1b[4];
    auto gload = [&](u32x4 (&ra)[4], u32x4 (&rb)[4], int st) {
        const char* a = ap + (size_t)st * 128; const char* b = bp + (size_t)st * 128;
#pragma unroll
        for (int i = 0; i < 4; ++i) { ra[i] = *(const u32x4*)(a + aoff + i * astep); rb[i] = *(const u32x4*)(b + boff + i * bstep); }
    };
    auto swrite = [&](const u32x4 (&ra)[4], const u32x4 (&rb)[4], int buf) {
#pragma unroll
        for (int i = 0; i < 4; ++i) { *(LDS u32x4*)(sm + buf * 65536 + soff + i * 8192) = ra[i]; *(LDS u32x4*)(sm + buf * 65536 + 32768 + soff + i * 8192) = rb[i]; }
    };
    const int arow = QUARTER ? (wave * 32 + r) * 128 : (wr * 128 + r) * 128, brow = 32768 + ((QUARTER ? q : wc) * 64 + r) * 128, swz = (r >> 1) & 7;
    auto compute = [&](int buf) {
#pragma unroll
        for (int ks = 0; ks < 4; ++ks) {
            const int ch = (((ks << 1) | hh) ^ swz) << 4;
            bf16x8 af[4], bfr[2];
#pragma unroll
            for (int t = 0; t < (QUARTER ? 1 : 4); ++t) af[t] = *(LDS bf16x8*)(sm + buf * 65536 + arow + t * 4096 + ch);
#pragma unroll
            for (int t = 0; t < 2; ++t) bfr[t] = *(LDS bf16x8*)(sm + buf * 65536 + brow + t * 4096 + ch);
#pragma unroll
            for (int mt = 0; mt < (QUARTER ? 1 : 4); ++mt)
#pragma unroll
                for (int nt = 0; nt < 2; ++nt) acc[mt][nt] = MFMA(af[mt], bfr[nt], acc[mt][nt]);
        }
    };
    gload(r0a, r0b, 0);
    if (nks > 1) gload(r1a, r1b, 1);
    swrite(r0a, r0b, 0);
    __syncthreads();
    if (nks > 2) gload(r0a, r0b, 2);
    for (int kt = 0; kt < nks; kt += 2) {
        compute(0);
        if (kt + 1 < nks) swrite(r1a, r1b, 1);
        __syncthreads();
        if (kt + 3 < nks) gload(r1a, r1b, kt + 3);
        if (kt + 1 < nks) {
            compute(1);
            if (kt + 2 < nks) swrite(r0a, r0b, 0);
            __syncthreads();
            if (kt + 4 < nks) gload(r0a, r0b, kt + 4);
        }
    }
}

template <int EPI>
DI void gemm_phase(const Params& P, int li, const GemmArgs g, bf16_t* __restrict__ C, int ldc) {
    int pm, pn, it = 0;
    for (; gemm_next(it, g.nM, g.nN, pm, pn); ++it) {
        const bf16_t* Ap = g.A + (size_t)(pm * 256) * g.lda + (size_t)pn * g.a_pn_stride;
        const bf16_t* Bp = g.Bt + (size_t)(pn * 256) * g.K;
        f32x16 acc[4][2];
        gemm_tile_loop<false>(Ap, g.lda, Bp, g.K, 0, g.K >> 6, acc);
        gemm_epilogue<EPI>(P, li, acc, pm, pn, C, ldc);
        if (EPI == EPI_GATES) {
            __syncthreads();
            const float* LA = (const float*)(P.ws + R_LA); const float* IU = (const float*)(P.ws + R_IU);
            float* SA = (float*)(P.ws + R_SEGA); float* SB = (float*)(P.ws + R_SEGB);
            const bool smp = pm == 128;
            const int nit = (smp ? 16 : 4) * 128, len = smp ? 16 : 64;
            for (int item = TIDX; item < nit; item += NT) {
                const int sl = item >> 7, ch = pn * 128 + (item & 127);
                const int seg = smp ? 512 + sl : pm * 4 + sl, row0 = smp ? MP + sl * 16 : pm * 256 + sl * 64;
                float h = 0.f, p = 1.f;
                for (int j0 = 0; j0 < len; j0 += 8) {
                    float la[8], iu[8];
#pragma unroll
                    for (int j = 0; j < 8; ++j) { la[j] = LA[(size_t)(row0 + j0 + j) * 512 + ch]; iu[j] = IU[(size_t)(row0 + j0 + j) * 512 + ch]; }
#pragma unroll
                    for (int j = 0; j < 8; ++j) {
                        const float a = __expf(la[j]), bx = sqrtf(-expm1f(2.0f * la[j])) * iu[j];
                        h = a * h + bx; p *= a;
                    }
                }
                SA[seg * 512 + ch] = p; SB[seg * 512 + ch] = h;
            }
        }
    }
    if (EPI == EPI_SWIGLU) {
        const int tid = TIDX, lane = tid & 63, wave = tid >> 6, r = lane & 31, hh = lane >> 5;
        for (int j = (int)gridDim.x - 1 - (int)blockIdx.x; j < g.nsk; j += gridDim.x) {
            const int pn2 = j >> 2, q = j & 3;
            const bf16_t* Ap = g.A + (size_t)MP * g.lda;
            const bf16_t* Bp = g.Bt + (size_t)(pn2 * 256) * g.K;
            f32x16 acc[4][2];
            gemm_tile_loop<true>(Ap, g.lda, Bp, g.K, 0, g.K >> 6, acc, q);
            const int jc = pn2 * 128 + q * 32 + r;
#pragma unroll
            for (int i = 0; i < 16; ++i) {
                const int row = MP + wave * 32 + crow(i, hh);
                const float gv = acc[0][0][i], uv = acc[0][1][i];
                C[(size_t)row * DFF + jc] = f2bf(gv / (1.0f + __expf(-gv)) * uv);
            }
        }
    }
    if (EPI == EPI_ODD_IN) {
        for (int j = (int)gridDim.x - 1 - (int)blockIdx.x; j < g.nsk; j += gridDim.x) {
            const int pn2 = j >> 2, q = j & 3;
            const bf16_t* Ap = g.A + (size_t)MP * g.lda;
            const bf16_t* Bp = g.Bt + (size_t)(pn2 * 256) * g.K;
            f32x16 acc[4][2];
            gemm_tile_loop<true>(Ap, g.lda, Bp, g.K, 0, g.K >> 6, acc, q);
            gemm_epilogue<EPI_ODD_IN, true>(P, li, acc, 128, pn2, nullptr, 0, q);
        }
    }
    if (EPI == EPI_PLAIN) {
        for (int j = (int)gridDim.x - 1 - (int)blockIdx.x; j < g.nsk; j += gridDim.x) {
            const int pn2 = j % g.nN, kc = j / g.nN;
            const bf16_t* Ap = g.A + (size_t)MP * g.lda;
            const bf16_t* Bp = g.Bt + (size_t)(pn2 * 256) * g.K;
            f32x16 acc[4][2];
            gemm_tile_loop<false>(Ap, g.lda, Bp, g.K, kc * g.skc, g.skc, acc);
            gemm_epilogue<EPI_SACC>(P, li, acc, 128, pn2, nullptr, 0);
        }
    }
}

DI void phase_conv(const Params& P, int e) {
    const float* __restrict__ U = (const float*)(P.ws + R_U);
    bf16_t* __restrict__ UC = (bf16_t*)(P.ws + R_UC);
    const float* cw = P.in[I_CW] + e * 4 * 512; const float* cbias = P.in[I_CB] + e * 512;
    const float* sbuf = P.in[I_SLC] + (size_t)e * 16 * 3 * 512;
    const int gtid = blockIdx.x * NT + TIDX, gsz = gridDim.x * NT;
    for (int idx = gtid; idx < MT * 128; idx += gsz) {
        const int row = idx >> 7, c = (idx & 127) * 4;
        int t, b; const bool samp = row >= MP;
        if (!samp) { t = row & 4095; b = row >> 12; } else { t = (row - MP) & 15; b = (row - MP) >> 4; }
        f32x4 acc = *(const f32x4*)(cbias + c);
#pragma unroll
        for (int j = 0; j < 4; ++j) {
            const int tt = t - 3 + j;
            f32x4 uv;
            if (tt >= 0) uv = *(const f32x4*)(U + (size_t)(row - 3 + j) * 512 + c);
            else if (samp) uv = *(const f32x4*)(sbuf + ((size_t)b * 3 + (3 + tt)) * 512 + c);
            else uv = (f32x4){0.f, 0.f, 0.f, 0.f};
            acc += uv * *(const f32x4*)(cw + j * 512 + c);
        }
        *(u32x2*)(UC + (size_t)row * 512 + c) = (u32x2){pk2(acc.x, acc.y), pk2(acc.z, acc.w)};
    }
    for (int idx = gtid; idx < (8 + 16) * 3 * 512; idx += gsz) {
        const int c = idx & 511, i = (idx >> 9) % 3, s = idx / 1536;
        if (s < 8) P.out[O_PLC + ((size_t)(e * 8 + s) * 3 + i) * 512 + c] = U[(size_t)(s * 4096 + 4093 + i) * 512 + c];
        else P.out[O_SLC + ((size_t)(e * 16 + (s - 8)) * 3 + i) * 512 + c] = U[(size_t)(MP + (s - 8) * 16 + 13 + i) * 512 + c];
    }
    const float* LF = (const float*)(P.ws + R_LOGF);
    float* CBP = (float*)(P.ws + R_CBP); float* CBS = (float*)(P.ws + R_CBS);
    const int lane = TIDX & 63;
    for (int w = blockIdx.x * NW + (TIDX >> 6); w < 64 + 128; w += gridDim.x * NW) {
        if (w < 64) {
            const int s = w >> 3, h = w & 7;
            float loc = 0.f;
            for (int j0 = 0; j0 < 64; j0 += 16) {
                float v[16];
#pragma unroll
                for (int j = 0; j < 16; ++j) v[j] = LF[(size_t)(s * 4096 + lane * 64 + j0 + j) * 8 + h];
#pragma unroll
                for (int j = 0; j < 16; ++j) loc += v[j];
            }
            float inc = loc;
#pragma unroll
            for (int o = 1; o < 64; o <<= 1) { const float t = __shfl_up(inc, o); if (lane >= o) inc += t; }
            float run = inc - loc;
            for (int j0 = 0; j0 < 64; j0 += 16) {
                float v[16];
#pragma unroll
                for (int j = 0; j < 16; ++j) v[j] = LF[(size_t)(s * 4096 + lane * 64 + j0 + j) * 8 + h];
#pragma unroll
                for (int j = 0; j < 16; ++j) { run += v[j]; v[j] = -run * LOG2E; }
#pragma unroll
                for (int j = 0; j < 16; ++j) CBP[(size_t)(s * 8 + h) * 4096 + lane * 64 + j0 + j] = v[j];
            }
        } else {
            const int b = (w - 64) >> 3, h = (w - 64) & 7;
            const float* cl = P.in[I_CFL] + (size_t)(e * 16 + b) * 1024 * 8;
            float loc = 0.f;
            for (int j = 0; j < 17; ++j) {
                const int k = lane * 17 + j;
                float v = 0.f;
                if (k < 1024) v = cl[(size_t)k * 8 + h]; else if (k < 1040) v = LF[(size_t)(MP + b * 16 + (k - 1024)) * 8 + h];
                loc += v;
            }
            float inc = loc;
#pragma unroll
            for (int o = 1; o < 64; o <<= 1) { const float t = __shfl_up(inc, o); if (lane >= o) inc += t; }
            float run = inc - loc;
            for (int j = 0; j < 17; ++j) {
                const int k = lane * 17 + j;
                float v = 0.f;
                if (k < 1024) v = cl[(size_t)k * 8 + h]; else if (k < 1040) v = LF[(size_t)(MP + b * 16 + (k - 1024)) * 8 + h];
                run += v;
                CBS[(size_t)(b * 8 + h) * KVS + k] = -run * LOG2E;
            }
        }
    }
}

DI void seg_info(int seg, int& row0, int& len) { if (seg < 512) { row0 = seg * 64; len = 64; } else { row0 = MP + (seg - 512) * 16; len = 16; } }

DI void phase_scan1(const Params& P) {
    const float* LA = (const float*)(P.ws + R_LA); const float* IU = (const float*)(P.ws + R_IU);
    float* SA = (float*)(P.ws + R_SEGA); float* SB = (float*)(P.ws + R_SEGB);
    for (int idx = blockIdx.x * NT + TIDX; idx < 528 * 512; idx += gridDim.x * NT) {
        const int seg = idx >> 9, c = idx & 511;
        int row0, len; seg_info(seg, row0, len);
        float h = 0.f, p = 1.f;
        for (int j0 = 0; j0 < len; j0 += 8) {
            float la[8], iu[8];
#pragma unroll
            for (int j = 0; j < 8; ++j) { la[j] = LA[(size_t)(row0 + j0 + j) * 512 + c]; iu[j] = IU[(size_t)(row0 + j0 + j) * 512 + c]; }
#pragma unroll
            for (int j = 0; j < 8; ++j) {
                const float a = __expf(la[j]), bx = sqrtf(-expm1f(2.0f * la[j])) * iu[j];
                h = a * h + bx; p *= a;
            }
        }
        SA[idx] = p; SB[idx] = h;
    }
}

DI void phase_scan3(const Params& P, int e) {
    const float* LA = (const float*)(P.ws + R_LA); const float* IU = (const float*)(P.ws + R_IU);
    const float* SA = (const float*)(P.ws + R_SEGA); const float* SB = (const float*)(P.ws + R_SEGB);
    const bf16_t* Gb = (const bf16_t*)(P.ws + R_G);
    bf16_t* MIX = (bf16_t*)(P.ws + OFF_HN);
    for (int idx = blockIdx.x * NT + TIDX; idx < 528 * 512; idx += gridDim.x * NT) {
        const int seg = idx >> 9, c = idx & 511;
        int row0, len; seg_info(seg, row0, len);
        float h = 0.f;
        if (seg < 512) {
            const int s0 = seg & ~63;
            for (int sb = s0; sb < seg; sb += 8) {
                float sa[8], sbv[8];
#pragma unroll
                for (int j = 0; j < 8; ++j) { const int sj = (sb + j < seg) ? sb + j : s0; sa[j] = SA[sj * 512 + c]; sbv[j] = SB[sj * 512 + c]; }
#pragma unroll
                for (int j = 0; j < 8; ++j) if (sb + j < seg) h = sa[j] * h + sbv[j];
            }
        }
        else h = P.in[I_SLH][(size_t)(e * 16 + (seg - 512)) * 512 + c];
        for (int j0 = 0; j0 < len; j0 += 8) {
            float la[8], iu[8], gg[8], y[8];
#pragma unroll
            for (int j = 0; j < 8; ++j) {
                la[j] = LA[(size_t)(row0 + j0 + j) * 512 + c]; iu[j] = IU[(size_t)(row0 + j0 + j) * 512 + c];
                gg[j] = bf2f(Gb[(size_t)(row0 + j0 + j) * 512 + c]);
            }
#pragma unroll
            for (int j = 0; j < 8; ++j) {
                const float a = __expf(la[j]), bx = sqrtf(-expm1f(2.0f * la[j])) * iu[j];
                h = a * h + bx; y[j] = h * gg[j];
            }
#pragma unroll
            for (int j = 0; j < 8; ++j) MIX[(size_t)(row0 + j0 + j) * 1024 + c] = f2bf(y[j]);
        }
        if (seg < 512) { if ((seg & 63) == 63) P.out[O_PLH + (size_t)(e * 8 + (seg >> 6)) * 512 + c] = h; }
        else P.out[O_SLH + (size_t)(e * 16 + (seg - 512)) * 512 + c] = h;
    }
}

template <int DV, bool BIAS>
DI void flash_pass(const bf16_t* __restrict__ Qb, int ldq, const bf16_t* __restrict__ Kb, int ldk, const bf16_t* __restrict__ Vb, int ldv,
                   const float* __restrict__ cb, int q0, int nq, int past, int mode, int kvlen, f32x16 (&O)[DV / 32], float& l_out) {
    constexpr int VSTR = (DV == 64) ? 192 : 320;
    constexpr int BUFSZ = 8192 + 64 * VSTR + 256;
    constexpr int VCH = DV / 8, NVL = (64 * VCH) / NT;
    const int tid = TIDX, lane = tid & 63, wave = tid >> 6, r = lane & 31, hh = lane >> 5;
    LDS char* sm = (LDS char*)smem;
    const int qw0 = q0 + wave * 32;
    const bool wactive = qw0 < nq;
    int qi = qw0 + r; if (qi > nq - 1) qi = nq - 1;
    const int qabs = past + qi;
    int klim = qabs; if (mode == 1) { klim = qabs | 63; if (klim > kvlen - 1) klim = kvlen - 1; }
    int qlw = qw0 + 31; if (qlw > nq - 1) qlw = nq - 1;
    int wkmax = past + qlw; if (mode == 1) { wkmax |= 63; if (wkmax > kvlen - 1) wkmax = kvlen - 1; }
    const int wkmin = (mode == 0) ? past + qw0 : wkmax;
    int qlb = q0 + NW * 32 - 1; if (qlb > nq - 1) qlb = nq - 1;
    int bkmax = past + qlb; if (mode == 1) { bkmax |= 63; if (bkmax > kvlen - 1) bkmax = kvlen - 1; }
    const int ntiles = (bkmax >> 6) + 1;

    bf16x8 qf[4];
#pragma unroll
    for (int ks = 0; ks < 4; ++ks) qf[ks] = *(const bf16x8*)(Qb + (size_t)qi * ldq + ks * 16 + hh * 8);
#pragma unroll
    for (int dt = 0; dt < DV / 32; ++dt)
#pragma unroll
        for (int i = 0; i < 16; ++i) O[dt][i] = 0.f;
    float m = -1e30f, l = 0.f;

    u32x4 rk[1], rv[NVL]; f32x4 rc4 = {0.f, 0.f, 0.f, 0.f};
    unsigned koff[1], vofs[NVL];
#pragma unroll
    for (int i = 0; i < 1; ++i) { const int idx = tid + NT * i, row = idx >> 3, c = idx & 7; koff[i] = (unsigned)(row * ldk + c * 8) * 2u; }
#pragma unroll
    for (int i = 0; i < NVL; ++i) { const int idx = tid + NT * i, row = idx / VCH, c = idx % VCH; vofs[i] = (unsigned)(row * ldv + c * 8) * 2u; }
    auto prefetch = [&](int kt) {
        const char* kp = (const char*)Kb + (size_t)kt * 128 * ldk;
        const char* vp = (const char*)Vb + (size_t)kt * 128 * ldv;
#pragma unroll
        for (int i = 0; i < 1; ++i) rk[i] = *(const u32x4*)(kp + koff[i]);
        if (DV == 64) {
#pragma unroll
            for (int i = 0; i < NVL; ++i) rv[i] = *(const u32x4*)(vp + vofs[i]);
        }
        if (BIAS) { if (tid < 16) rc4 = *(const f32x4*)(cb + kt * 64 + tid * 4); }
    };
    auto late_v = [&](int kt) {
        if (DV != 64) {
            const char* vp = (const char*)Vb + (size_t)kt * 128 * ldv;
#pragma unroll
            for (int i = 0; i < NVL; ++i) rv[i] = *(const u32x4*)(vp + vofs[i]);
        }
    };
    auto stash = [&](int buf) {
        LDS char* b = sm + buf * BUFSZ;
#pragma unroll
        for (int i = 0; i < 1; ++i) { const int idx = tid + NT * i, row = idx >> 3, c = idx & 7; *(LDS u32x4*)(b + row * 128 + ((c ^ ((row >> 1) & 7)) << 4)) = rk[i]; }
#pragma unroll
        for (int i = 0; i < NVL; ++i) { const int idx = tid + NT * i, row = idx / VCH, c = idx % VCH; *(LDS u32x4*)(b + 8192 + row * VSTR + c * 16) = rv[i]; }
        if (BIAS) { if (tid < 16) *(LDS f32x4*)(b + 8192 + 64 * VSTR + tid * 16) = rc4; }
    };
    prefetch(0); late_v(0); stash(0); __syncthreads();
    const int q4 = (lane & 15) >> 2, p4 = lane & 3, g1 = (lane >> 4) & 1;
    const int voff = (4 * hh + q4) * VSTR + (16 * g1 + 4 * p4) * 2;
    for (int kt = 0; kt < ntiles; ++kt) {
        if (kt + 1 < ntiles) prefetch(kt + 1);
        if (wactive && kt * 64 <= wkmax) {
            LDS char* kb = sm + (kt & 1) * BUFSZ; LDS char* vb = kb + 8192; LDS char* cbp = vb + 64 * VSTR;
            const bool need_mask = kt * 64 + 63 > wkmin;
#pragma unroll
            for (int st = 0; st < 2; ++st) {
                asm volatile("" ::: "memory");
                f32x16 S;
#pragma unroll
                for (int i = 0; i < 16; ++i) S[i] = 0.f;
#pragma unroll
                for (int ks = 0; ks < 4; ++ks) {
                    const bf16x8 a = *(LDS bf16x8*)(kb + (st * 32 + r) * 128 + ((((ks << 1) | hh) ^ ((r >> 1) & 7)) << 4));
                    S = MFMA(a, qf[ks], S);
                }
                if (BIAS) {
#pragma unroll
                    for (int g = 0; g < 4; ++g) {
                        const f32x4 c4 = *(LDS f32x4*)(cbp + (st * 32 + 8 * g + 4 * hh) * 4);
                        S[4 * g + 0] += c4.x; S[4 * g + 1] += c4.y; S[4 * g + 2] += c4.z; S[4 * g + 3] += c4.w;
                    }
                }
                if (need_mask) {
#pragma unroll
                    for (int i = 0; i < 16; ++i) { const int key = kt * 64 + st * 32 + crow(i, hh); if (key > klim) S[i] = -1e30f; }
                }
                float mx = S[0];
#pragma unroll
                for (int i = 1; i < 16; ++i) mx = fmaxf(mx, S[i]);
                mx = fmaxf(mx, __shfl_xor(mx, 32));
                if (__any(mx > m)) {
                    const float mn = fmaxf(m, mx);
                    const float alpha = __builtin_amdgcn_exp2f(m - mn);
                    m = mn; l *= alpha;
#pragma unroll
                    for (int dt = 0; dt < DV / 32; ++dt)
#pragma unroll
                        for (int i = 0; i < 16; ++i) O[dt][i] *= alpha;
                }
                float ps = 0.f;
#pragma unroll
                for (int i = 0; i < 16; ++i) { const float p = __builtin_amdgcn_exp2f(S[i] - m); S[i] = p; ps += p; }
                l += ps;
                bf16x8 pf[2];
#pragma unroll
                for (int s = 0; s < 2; ++s) {
                    const u32x4 w = {pk2(S[8 * s + 0], S[8 * s + 1]), pk2(S[8 * s + 2], S[8 * s + 3]), pk2(S[8 * s + 4], S[8 * s + 5]), pk2(S[8 * s + 6], S[8 * s + 7])};
                    pf[s] = __builtin_bit_cast(bf16x8, w);
                }
#pragma unroll
                for (int dt = 0; dt < DV / 32; ++dt) {
                    if (DV > 64) asm volatile("" ::: "memory");
#pragma unroll
                    for (int s = 0; s < 2; ++s) {
                        const s16x4 lo = __builtin_amdgcn_ds_read_tr16_b64_v4i16((LDS s16x4*)(vb + voff + (st * 32 + s * 16) * VSTR + dt * 64));
                        const s16x4 hi = __builtin_amdgcn_ds_read_tr16_b64_v4i16((LDS s16x4*)(vb + voff + (st * 32 + s * 16 + 8) * VSTR + dt * 64));
                        const bf16x8 a = __builtin_shufflevector(lo, hi, 0, 1, 2, 3, 4, 5, 6, 7);
                        O[dt] = MFMA(a, pf[s], O[dt]);
                    }
                }
            }
        }
        if (kt + 1 < ntiles) { late_v(kt + 1); stash((kt + 1) & 1); }
        __syncthreads();
    }
    l_out = l + __shfl_xor(l, 32);
}

DI int next_unit(unsigned* ctr) {
    LDS int* su = (LDS int*)((LDS char*)smem + 65528);
    if (TIDX == 0) *su = (int)atomicAdd(ctr, 1u);
    __syncthreads();
    const int u = *su;
    __syncthreads();
    return u;
}

DI int attn_unit(unsigned* ctr, int iter) {
    if (gridDim.x == 256) {
        if (iter < 4) {
            const int g = blockIdx.x >> 6, sh = blockIdx.x & 63;
            const int qb = (iter == 0) ? 15 - g : (iter == 1) ? 8 + g : (iter == 2) ? 7 - g : g;
            return 128 + (15 - qb) * 64 + sh;
        }
        const int u = next_unit(ctr);
        return u < 128 ? u : -1;
    }
    const int u = next_unit(ctr);
    return u < 128 + 1024 ? u : -1;
}

DI void unit_decode(int u, int& samp, int& s, int& h, int& qb) {
    if (u < 128) { samp = 1; s = u >> 3; h = u & 7; qb = 0; }
    else { const int v = u - 128; samp = 0; qb = 15 - (v >> 6); s = (v & 63) >> 3; h = v & 7; }
}

DI void phase_fox_attn(const Params& P, unsigned* ctr) {
    const bf16_t* QE = (const bf16_t*)(P.ws + R_QE);
    bf16_t* MIX = (bf16_t*)(P.ws + OFF_HN);
    const int lane = TIDX & 63, wave = TIDX >> 6, r = lane & 31, hh = lane >> 5;
    for (int iter = 0;; ++iter) {
        const int u = attn_unit(ctr, iter);
        if (u < 0) break;
        int samp, s, h, qb; unit_decode(u, samp, s, h, qb);
        const bf16_t *Qb, *Kb, *Vb; const float* cb; int nq, past, kvlen, row0;
        if (!samp) {
            row0 = s * 4096; nq = 4096; past = 0; kvlen = 4096;
            Kb = (const bf16_t*)(P.ws + R_KE) + (size_t)row0 * 512 + h * 64; Vb = (const bf16_t*)(P.ws + R_VE) + (size_t)row0 * 512 + h * 64;
            cb = (const float*)(P.ws + R_CBP) + (size_t)(s * 8 + h) * 4096;
        } else {
            row0 = MP + s * 16; nq = 16; past = 1024; kvlen = 1040;
            Kb = (const bf16_t*)(P.ws + OFF_KS) + (size_t)s * KVS * 512 + h * 64; Vb = (const bf16_t*)(P.ws + OFF_VS) + (size_t)s * KVS * 512 + h * 64;
            cb = (const float*)(P.ws + R_CBS) + (size_t)(s * 8 + h) * KVS;
        }
        Qb = QE + (size_t)row0 * 512 + h * 64;
        f32x16 O[2]; float l;
        flash_pass<64, true>(Qb, 512, Kb, 512, Vb, 512, cb, qb * 256, nq, past, 0, kvlen, O, l);
        const int qi = qb * 256 + wave * 32 + r;
        if (qi < nq) {
            const float inv = 1.0f / l;
            bf16_t* dst = MIX + (size_t)(row0 + qi) * 1024 + 512 + h * 64;
#pragma unroll
            for (int dt = 0; dt < 2; ++dt)
#pragma unroll
                for (int g = 0; g < 4; ++g)
                    *(u32x2*)(dst + dt * 32 + 8 * g + 4 * hh) = (u32x2){pk2(O[dt][4 * g] * inv, O[dt][4 * g + 1] * inv), pk2(O[dt][4 * g + 2] * inv, O[dt][4 * g + 3] * inv)};
        }
    }
}

DI void phase_diff_attn(const Params& P, int o, int layer, unsigned* ctr) {
    const bf16_t* QO = (const bf16_t*)(P.ws + R_QO);
    float* O1 = (float*)(P.ws + R_O1);
    bf16_t* MIX = (bf16_t*)(P.ws + OFF_HN);
    const int lane = TIDX & 63, wave = TIDX >> 6, r = lane & 31, hh = lane >> 5;
    const float lam_init = 0.8f - 0.6f * expf(-0.3f * (float)layer);
    const float* lp = P.in[I_DLAM] + o * 256;
    const float s1 = wave_sum(lp[lane] * lp[64 + lane]), s2 = wave_sum(lp[128 + lane] * lp[192 + lane]);
    const float lam = expf(s1) - expf(s2) + lam_init;
    const float* sg = P.in[I_SUBG] + o * 128;
    for (int iter = 0;; ++iter) {
        const int u = attn_unit(ctr, iter);
        if (u < 0) break;
        int samp, s, h, qb; unit_decode(u, samp, s, h, qb);
        const bf16_t *Kb, *Vb; int nq, past, kvlen, row0;
        if (!samp) {
            row0 = s * 4096; nq = 4096; past = 0; kvlen = 4096;
            Kb = (const bf16_t*)(P.ws + R_KO) + (size_t)row0 * 1024 + h * 128; Vb = (const bf16_t*)(P.ws + R_VO) + (size_t)row0 * 1024 + h * 128;
        } else {
            row0 = MP + s * 16; nq = 16; past = 1024; kvlen = 1040;
            Kb = (const bf16_t*)(P.ws + OFF_KS) + (size_t)s * KVS * 1024 + h * 128; Vb = (const bf16_t*)(P.ws + OFF_VS) + (size_t)s * KVS * 1024 + h * 128;
        }
        const bf16_t* Qb = QO + (size_t)row0 * 1024 + h * 128;
        const int qi = qb * 256 + wave * 32 + r;
        const unsigned rowc = (unsigned)(row0 + (qi < nq ? qi : nq - 1));
        const unsigned o1off = (rowc * 1024u + (unsigned)(h * 128 + 4 * hh)) * 4u;
        const unsigned mixoff = (rowc * 1024u + (unsigned)(h * 128 + 4 * hh)) * 2u;
        for (int c = 0; c < 2; ++c) {
            f32x16 O[4]; float l;
            flash_pass<128, false>(Qb + c * 64, 1024, Kb + c * 64, 1024, Vb, 1024, nullptr, qb * 256, nq, past, 1, kvlen, O, l);
            if (qi < nq) {
                const float inv = 1.0f / l;
                char* o1p = (char*)O1 + o1off;
                if (c == 0) {
#pragma unroll
                    for (int dt = 0; dt < 4; ++dt)
#pragma unroll
                        for (int g = 0; g < 4; ++g)
                            *(f32x4*)(o1p + (dt * 32 + 8 * g) * 4) = (f32x4){O[dt][4 * g] * inv, O[dt][4 * g + 1] * inv, O[dt][4 * g + 2] * inv, O[dt][4 * g + 3] * inv};
                } else {
                    float ss = 0.f;
                    const float nl = -lam * inv;
#pragma unroll
                    for (int dt = 0; dt < 4; ++dt)
#pragma unroll
                        for (int i = 0; i < 16; ++i) O[dt][i] *= nl;
#pragma unroll
                    for (int dt = 0; dt < 4; ++dt) {
#pragma unroll
                        for (int g = 0; g < 4; ++g) {
                            const f32x4 a = *(const f32x4*)(o1p + (dt * 32 + 8 * g) * 4);
#pragma unroll
                            for (int j = 0; j < 4; ++j) { const float v = a[j] + O[dt][4 * g + j]; O[dt][4 * g + j] = v; ss += v * v; }
                        }
                        asm volatile("" : "+v"(ss) :: "memory");
                    }
                    ss += __shfl_xor(ss, 32);
                    const float rstd = rsqrtf(ss * (1.0f / 128.0f) + EPSN) * (1.0f - lam_init);
                    char* dst = (char*)MIX + mixoff;
                    const char* sgp = (const char*)sg + hh * 16;
#pragma unroll
                    for (int dt = 0; dt < 4; ++dt) {
                        asm volatile("" ::: "memory");
#pragma unroll
                        for (int g = 0; g < 4; ++g) {
                            const f32x4 gg = *(const f32x4*)(sgp + (dt * 32 + 8 * g) * 4);
                            *(u32x2*)(dst + (dt * 32 + 8 * g) * 2) = (u32x2){pk2(O[dt][4 * g] * rstd * gg.x, O[dt][4 * g + 1] * rstd * gg.y), pk2(O[dt][4 * g + 2] * rstd * gg.z, O[dt][4 * g + 3] * rstd * gg.w)};
                        }
                        asm volatile("" ::: "memory");
                    }
                }
            }
        }
    }
}


#define XB_TMO      128
#define XB_XCNT(j)  (256  + 64 * (j))
#define XB_XSUB(j)  (1280 + 64 * (j))
#define XB_XGEN(j)  (2304 + 64 * (j))
#define XB_TOP      3328
#define XB_TOPGEN   3392
#define XCD_BAR_WORDS 3456
#define XB_SPIN_CAP (1u << 22)
DI unsigned xb_ld(unsigned* p) { return __hip_atomic_load(p, __ATOMIC_RELAXED, __HIP_MEMORY_SCOPE_AGENT); }
DI unsigned xb_add(unsigned* p, unsigned v) { return __hip_atomic_fetch_add(p, v, __ATOMIC_RELAXED, __HIP_MEMORY_SCOPE_AGENT); }
DI unsigned xb_xcc_id() { return (unsigned)__builtin_amdgcn_s_getreg((3 << 11) | 20) & 0xFu; }
#define XB_SPIN(cond, bar) do { unsigned _sp = 0; while (cond) { __builtin_amdgcn_s_sleep(1); \
    if ((++_sp & 255u) == 0u) { if (xb_ld(&(bar)[XB_TMO])) break; if (_sp > XB_SPIN_CAP) { atomicAdd(&(bar)[XB_TMO], 1u); break; } } } } while (0)
__shared__ __attribute__((aligned(16))) unsigned xb_words[4];
struct XcdBarrier { unsigned* bar; unsigned x; };
DI XcdBarrier xcd_barrier_post(unsigned* bar) {
    XcdBarrier b; b.bar = bar; b.x = xb_xcc_id();
    if (threadIdx.x == 0) (void)xb_add(&bar[XB_XCNT(b.x)], 1u);
    return b;
}
DI void xcd_barrier_complete(unsigned* bar, unsigned x, unsigned& nloc, unsigned& nx) {
    const unsigned G = gridDim.x * gridDim.y * gridDim.z;
    unsigned sum, cnt, mine, sp = 0u;
    for (;;) {
        sum = 0u; cnt = 0u; mine = 0u;
#pragma unroll
        for (unsigned j = 0; j < 16; ++j) { const unsigned c = xb_ld(&bar[XB_XCNT(j)]); sum += c; cnt += (c > 0u) ? 1u : 0u; mine = (j == x) ? c : mine; }
        if (sum == G) break;
        __builtin_amdgcn_s_sleep(1);
        if ((++sp & 255u) == 0u) { if (xb_ld(&bar[XB_TMO])) break; if (sp > XB_SPIN_CAP) { atomicAdd(&bar[XB_TMO], 1u); break; } }
    }
    nloc = mine > 0u ? mine : 1u; nx = cnt > 0u ? cnt : 1u;
}
DI void xcd_barrier(const XcdBarrier& b) {
    volatile LDS unsigned* st = (volatile LDS unsigned*)xb_words;
    asm volatile("s_waitcnt vmcnt(0)" ::: "memory");
    __syncthreads();
    if (threadIdx.x == 0) {
        unsigned* bar = b.bar;
        __builtin_amdgcn_s_waitcnt(0);
        unsigned nloc = st[0], nx = st[1];
        if (nloc == 0u) { xcd_barrier_complete(bar, b.x, nloc, nx); st[0] = nloc; st[1] = nx; }
        const unsigned old = xb_add(&bar[XB_XSUB(b.x)], 1u);
        const unsigned gen = old / nloc;
        if (old + 1u == (gen + 1u) * nloc) {
            __builtin_amdgcn_fence(__ATOMIC_RELEASE, "agent");
            asm volatile("s_waitcnt vmcnt(0)" ::: "memory");
            const unsigned og = xb_add(&bar[XB_TOP], 1u);
            const unsigned tg = og / nx;
            if (og + 1u == (tg + 1u) * nx) xb_add(&bar[XB_TOPGEN], 1u);
            else XB_SPIN(xb_ld(&bar[XB_TOPGEN]) == tg, bar);
            __builtin_amdgcn_fence(__ATOMIC_ACQUIRE, "agent");
            xb_add(&bar[XB_XGEN(b.x)], 1u);
            asm volatile("s_waitcnt vmcnt(0)" ::: "memory");
        } else {
            XB_SPIN(xb_ld(&bar[XB_XGEN(b.x)]) == gen, bar);
            __builtin_amdgcn_fence(__ATOMIC_ACQUIRE, "agent");
            asm volatile("s_waitcnt vmcnt(0)" ::: "memory");
        }
    }
    __syncthreads();
}

constexpr int NPHASE = 45;
DI void run_phase(const Params& P, int ph) {
    unsigned* ctrl = (unsigned*)(P.ws + OFF_CTRL);
    if (ph == 0) {
        phase_prologue(P);
        phase_norm(P, 0, 0.f, nullptr, P.in[I_NG]);
        return;
    }
    int q = ph - 1, l, st;
    if (q < 12) { l = 0; st = q; } else if (q < 22) { l = 1; st = q - 12; } else if (q < 34) { l = 2; st = q - 22; } else { l = 3; st = q - 34; }
    const bool even = (l & 1) == 0; const int li = l >> 1;
    const float* ng = P.in[I_NG] + (size_t)l * 6 * DM;
    const bf16_t* HN = (const bf16_t*)(P.ws + OFF_HN);
    bf16_t* OUT = (bf16_t*)(P.ws + OFF_OUT);
    bf16_t* ACT = (bf16_t*)(P.ws + R_ACT);
    const bf16_t* wfi = (const bf16_t*)(P.ws + OFF_WT_FFN_IN); const bf16_t* wfo = (const bf16_t*)(P.ws + OFF_WT_FFN_OUT);
    const int nst = even ? 12 : 10;
    if (st == 0 || st == nst - 3) {
        const int f = (st == 0) ? 0 : 1;
        GemmArgs g{HN, DM, 0, wfi + (size_t)(l * 2 + f) * 5632 * 1024, 1024, 128, 22, 88, 0};
        gemm_phase<EPI_SWIGLU>(P, 0, g, ACT, DFF);
    } else if (st == 1 || st == nst - 2) {
        const int f = (st == 1) ? 0 : 1;
        GemmArgs g{ACT, DFF, 0, wfo + (size_t)(l * 2 + f) * 1024 * DFF, DFF, 128, 4, 176, 1};
        gemm_phase<EPI_PLAIN>(P, 0, g, OUT, DM);
    } else if (st == 2) {
        phase_norm(P, 1, 0.5f, ng + 1 * DM, ng + 2 * DM);
        if (even) cache_prep(P.in[I_CFK] + (size_t)li * 16 * 1024 * 512, P.in[I_CFV] + (size_t)li * 16 * 1024 * 512, (bf16_t*)(P.ws + OFF_KS), (bf16_t*)(P.ws + OFF_VS), 512);
        else cache_prep(P.in[I_CDK] + (size_t)li * 16 * 1024 * 1024, P.in[I_CDV] + (size_t)li * 16 * 1024 * 1024, (bf16_t*)(P.ws + OFF_KS), (bf16_t*)(P.ws + OFF_VS), 1024);
    } else if (st == nst - 1) {
        phase_norm(P, 1, 0.5f, ng + 5 * DM, (l < 3) ? ng + 6 * DM : nullptr);
    } else if (st == nst - 4) {
        phase_norm(P, 1, 1.0f, ng + 3 * DM, ng + 4 * DM);
    } else if (st == nst - 5) {
        const bf16_t* wo = even ? (const bf16_t*)(P.ws + OFF_WT_OUT_EVEN) : (const bf16_t*)(P.ws + OFF_WT_OUT_ODD);
        GemmArgs g{HN, DM, 0, wo + (size_t)li * 1024 * 1024, 1024, 128, 4, 64, 1};
        gemm_phase<EPI_PLAIN>(P, 0, g, OUT, DM);
    } else if (even) {
        if (st == 3) {
            GemmArgs g{HN, DM, 0, (const bf16_t*)(P.ws + OFF_WT_IN_EVEN) + (size_t)li * 2816 * 1024, 1024, 129, 11, 0, 0};
            gemm_phase<EPI_EVEN_IN>(P, li, g, nullptr, 0);
        } else if (st == 4) {
            phase_conv(P, li);
        } else if (st == 5) {
            GemmArgs g{(const bf16_t*)(P.ws + R_UC), 512, 128, (const bf16_t*)(P.ws + OFF_WT_GATES) + (size_t)li * 4 * 256 * 128, 128, 129, 4, 0, 0};
            gemm_phase<EPI_GATES>(P, li, g, nullptr, 0);
        } else if (st == 6) {
            phase_scan3(P, li);
            phase_fox_attn(P, ctrl + 16 * l);
        }
    } else {
        if (st == 3) {
            GemmArgs g{HN, DM, 0, (const bf16_t*)(P.ws + OFF_WT_IN_ODD) + (size_t)li * 3072 * 1024, 1024, 128, 12, 48, 0};
            gemm_phase<EPI_ODD_IN>(P, li, g, nullptr, 0);
        } else if (st == 4) {
            phase_diff_attn(P, li, l, ctrl + 16 * l);
        }
    }
}

#if MULTI_LAUNCH
__global__ void __launch_bounds__(512, 2) phase_kernel(Params P, int ph) { run_phase(P, ph); }
#else
__global__ void __launch_bounds__(512, 2) mega_kernel(Params P) {
    cg::grid_group grid = cg::this_grid();
    if (threadIdx.x < 4) xb_words[threadIdx.x] = 0u;
    __syncthreads();
    const XcdBarrier xb = xcd_barrier_post((unsigned*)(P.ws + OFF_BAR));
    for (int ph = 0; ph < NPHASE; ++ph) {
        run_phase(P, ph);
        if (ph == 0) grid.sync();
        else if (ph + 1 < NPHASE) xcd_barrier(xb);
    }
}
#endif

extern "C" void kernel_launch(void* const* d_in, const int* in_sizes, int n_in, void* d_out, int out_size, void* d_ws, size_t ws_size,
                              hipStream_t stream) {
    Params p{};
    for (int i = 0; i < 24; ++i) p.in[i] = (const float*)d_in[i];
    p.out = (float*)d_out; p.ws = (char*)d_ws;
    if (ws_size < WS_NEEDED) fprintf(stderr, "workspace too small: %zu < %zu\n", ws_size, (size_t)WS_NEEDED);
    hipMemsetAsync(d_ws, 0, 20480, stream);
    static int grid_blocks = 0;
    if (!grid_blocks) {
        int dev = 0, cus = 0, per_cu = 0;
        hipGetDevice(&dev);
        hipDeviceGetAttribute(&cus, hipDeviceAttributeMultiprocessorCount, dev);
#if MULTI_LAUNCH
        hipOccupancyMaxActiveBlocksPerMultiprocessor(&per_cu, phase_kernel, NT, 0);
#else
        hipOccupancyMaxActiveBlocksPerMultiprocessor(&per_cu, mega_kernel, NT, 0);
#endif
        if (per_cu < 1) per_cu = 1;
        if (per_cu > 1) per_cu = 1;
        grid_blocks = cus * per_cu;
    }
#if MULTI_LAUNCH
    for (int ph = 0; ph < NPHASE; ++ph) phase_kernel<<<grid_blocks, NT, 0, stream>>>(p, ph);
#else
    void* args[] = {&p};
    hipError_t e = hipLaunchCooperativeKernel((void*)mega_kernel, dim3(grid_blocks), dim3(NT), args, 0, stream);
    if (e != hipSuccess) fprintf(stderr, "cooperative launch failed: %s (grid %d)\n", hipGetErrorString(e), grid_blocks);
#endif
}
```

```cpp
#include <hip/hip_runtime.h>
#include <hip/hip_cooperative_groups.h>
#include <cstdio>
#include <cstdint>
namespace cg = cooperative_groups;

#ifndef MULTI_LAUNCH
#define MULTI_LAUNCH 0
#endif

#define DI __device__ __forceinline__
#define LDS __attribute__((address_space(3)))
typedef unsigned short bf16_t;
typedef short bf16x8 __attribute__((ext_vector_type(8)));
typedef short s16x4 __attribute__((ext_vector_type(4)));
typedef float f32x16 __attribute__((ext_vector_type(16)));
typedef float f32x4 __attribute__((ext_vector_type(4)));
typedef float f32x2 __attribute__((ext_vector_type(2)));
typedef unsigned u32x4 __attribute__((ext_vector_type(4)));
typedef unsigned u32x2 __attribute__((ext_vector_type(2)));
typedef __bf16 bf2_t __attribute__((ext_vector_type(2)));
#define MFMA(a, b, c) __builtin_amdgcn_mfma_f32_32x32x16_bf16((a), (b), (c), 0, 0, 0)

constexpr int MP = 32768, MS = 256, MT = 33024;
constexpr int DM = 1024, DFF = 2816;
constexpr float LOG2E = 1.4426950408889634f;
constexpr float EPSN = 1e-6f;
constexpr int NT = 512, NW = 8;
constexpr int KVS = 1088;

constexpr size_t OFF_CTRL = 0;
constexpr size_t OFF_BAR = 4096;
constexpr size_t OFF_ROPE = 20480;
constexpr size_t OFF_WT_FFN_IN = OFF_ROPE + 262144;
constexpr size_t OFF_WT_FFN_OUT = OFF_WT_FFN_IN + 92274688;
constexpr size_t OFF_WT_IN_EVEN = OFF_WT_FFN_OUT + 46137344;
constexpr size_t OFF_WT_OUT_EVEN = OFF_WT_IN_EVEN + 11534336;
constexpr size_t OFF_WT_IN_ODD = OFF_WT_OUT_EVEN + 4194304;
constexpr size_t OFF_WT_OUT_ODD = OFF_WT_IN_ODD + 12582912;
constexpr size_t OFF_WT_GATES = OFF_WT_OUT_ODD + 4194304;
constexpr size_t OFF_SACC = OFF_WT_GATES + 524288;
constexpr size_t OFF_HN = OFF_SACC + 1048576;
constexpr size_t OFF_OUT = OFF_HN + 67633152;
constexpr size_t OFF_KS = OFF_OUT + 67633152;
constexpr size_t OFF_VS = OFF_KS + 35651584;
constexpr size_t OFF_R = OFF_VS + 35651584;
constexpr size_t R_ACT = OFF_R;
constexpr size_t R_U = OFF_R;
constexpr size_t R_G = R_U + 67633152;
constexpr size_t R_QE = R_G + 33816576;
constexpr size_t R_KE = R_QE + 33816576;
constexpr size_t R_VE = R_KE + 33554432;
constexpr size_t R_LOGF = R_VE + 33554432;
constexpr size_t R_CBP = R_LOGF + 1056768;
constexpr size_t R_CBS = R_CBP + 1048576;
constexpr size_t R_UC = R_CBS + 557056;
constexpr size_t R_LA = R_UC + 33816576;
constexpr size_t R_IU = R_LA + 67633152;
constexpr size_t R_SEGA = R_IU + 67633152;
constexpr size_t R_SEGB = R_SEGA + 1081344;
constexpr size_t R_EVEN_END = R_SEGB + 1081344;
constexpr size_t R_QO = OFF_R;
constexpr size_t R_KO = R_QO + 67633152;
constexpr size_t R_VO = R_KO + 67108864;
constexpr size_t R_O1 = R_VO + 67108864;
constexpr size_t R_ODD_END = R_O1 + 135266304;
constexpr size_t WS_NEEDED = (R_EVEN_END > R_ODD_END ? R_EVEN_END : R_ODD_END);

constexpr size_t O_Y = 0;
constexpr size_t O_PFK = O_Y + (size_t)MT * 1024;
constexpr size_t O_PFV = O_PFK + 33554432;
constexpr size_t O_PFL = O_PFV + 33554432;
constexpr size_t O_PLH = O_PFL + 524288;
constexpr size_t O_PLC = O_PLH + 8192;
constexpr size_t O_PDK = O_PLC + 24576;
constexpr size_t O_PDV = O_PDK + 67108864;
constexpr size_t O_SFK = O_PDV + 67108864;
constexpr size_t O_SFV = O_SFK + 262144;
constexpr size_t O_SFL = O_SFV + 262144;
constexpr size_t O_SLH = O_SFL + 4096;
constexpr size_t O_SLC = O_SLH + 16384;
constexpr size_t O_SDK = O_SLC + 49152;
constexpr size_t O_SDV = O_SDK + 524288;

enum { I_XP = 0, I_XS, I_CFK, I_CFV, I_CFL, I_SLH, I_SLC, I_CDK, I_CDV, I_NG, I_WFI, I_WFO, I_WIE, I_BFF, I_CW, I_CB, I_WG, I_BG,
       I_LAM, I_WOE, I_WIO, I_DLAM, I_SUBG, I_WOO };

struct Params {
    const float* in[24];
    float* out;
    char* ws;
};

__shared__ __attribute__((aligned(16))) char smem[131072];

DI int tid_opaque() { int t = threadIdx.x; asm volatile("" : "+v"(t)); return t; }
#define TIDX tid_opaque()
DI float bf2f(bf16_t x) { return __uint_as_float(((unsigned)x) << 16); }
DI unsigned pk2(float lo, float hi) { f32x2 v = {lo, hi}; bf2_t b = __builtin_convertvector(v, bf2_t); return __builtin_bit_cast(unsigned, b); }
DI bf16_t f2bf(float x) { return (bf16_t)(pk2(x, 0.f) & 0xffffu); }
DI float wave_sum(float v) {
#pragma unroll
    for (int o = 32; o >= 1; o >>= 1) v += __shfl_xor(v, o);
    return v;
}
DI float sigmoidf_(float x) { return 1.0f / (1.0f + __expf(-x)); }
DI float softplusf_(float x) { return fmaxf(x, 0.f) + log1pf(__expf(-fabsf(x))); }
DI float gelu_tanh(float x) { const float u = 0.7978845608028654f * (x + 0.044715f * x * x * x); return x / (1.0f + __expf(-2.0f * u)); }
DI int crow(int i, int hh) { return (i & 3) + 8 * (i >> 2) + 4 * hh; }

struct WtJob { const float* src; bf16_t* dst; int K, Ns, mode, p0, k0; };
DI WtJob wt_decode(const Params& P, int t) {
    int tt = t, g;
    if (tt < 11264) g = 0; else if ((tt -= 11264) < 5632) g = 1; else if ((tt -= 5632) < 1408) g = 2; else if ((tt -= 1408) < 512) g = 3;
    else if ((tt -= 512) < 1536) g = 4; else { tt -= 1536; g = 5; }
    const float* src; bf16_t* dst; int K = 1024, Ns = 1024, Nd = 1024, mode = 0;
    switch (g) {
        case 0: src = P.in[I_WFI]; dst = (bf16_t*)(P.ws + OFF_WT_FFN_IN); mode = 1; Ns = 5632; Nd = 5632; break;
        case 1: src = P.in[I_WFO]; dst = (bf16_t*)(P.ws + OFF_WT_FFN_OUT); K = 2816; break;
        case 2: src = P.in[I_WIE]; dst = (bf16_t*)(P.ws + OFF_WT_IN_EVEN); Ns = 2568; Nd = 2816; break;
        case 3: src = P.in[I_WOE]; dst = (bf16_t*)(P.ws + OFF_WT_OUT_EVEN); break;
        case 4: src = P.in[I_WIO]; dst = (bf16_t*)(P.ws + OFF_WT_IN_ODD); Ns = 3072; Nd = 3072; break;
        default: src = P.in[I_WOO]; dst = (bf16_t*)(P.ws + OFF_WT_OUT_ODD); break;
    }
    const int npt = Nd / 64, tpm = npt * (K / 64);
    const int mat = tt / tpm, ti = tt % tpm;
    WtJob j; j.src = src + (size_t)mat * K * Ns; j.dst = dst + (size_t)mat * Nd * K; j.K = K; j.Ns = Ns; j.mode = mode; j.p0 = (ti % npt) * 64; j.k0 = (ti / npt) * 64;
    return j;
}
DI void wt_load(const WtJob& j, float (&v)[8]) {
    const int tid = TIDX;
#pragma unroll
    for (int q = 0; q < 8; ++q) {
        const int idx = tid + NT * q, kk = idx >> 6, pp = idx & 63, p = j.p0 + pp;
        int col = p;
        if (j.mode == 1) { const int pn = p >> 8, w = p & 255; col = ((w >> 5) & 1) * DFF + pn * 128 + (w >> 6) * 32 + (w & 31); }
        v[q] = (col < j.Ns) ? j.src[(size_t)(j.k0 + kk) * j.Ns + col] : 0.f;
    }
}
DI void wt_store(const WtJob& j, const float (&v)[8]) {
    float* T = (float*)smem;
    const int tid = TIDX;
#pragma unroll
    for (int q = 0; q < 8; ++q) { const int idx = tid + NT * q; T[(idx >> 6) * 65 + (idx & 63)] = v[q]; }
    __syncthreads();
    {
        const int pp = tid >> 3, ks = (tid & 7) * 8;
        unsigned w[4];
#pragma unroll
        for (int q = 0; q < 4; ++q) w[q] = pk2(T[(ks + 2 * q) * 65 + pp], T[(ks + 2 * q + 1) * 65 + pp]);
        *(u32x4*)(j.dst + (size_t)(j.p0 + pp) * j.K + j.k0 + ks) = (u32x4){w[0], w[1], w[2], w[3]};
    }
    __syncthreads();
}

DI void phase_prologue(const Params& P) {
    const int total = 20864;
    {
        int t = blockIdx.x;
        WtJob job{}; float cur[8];
        if (t < total) { job = wt_decode(P, t); wt_load(job, cur); }
        for (; t < total; t += gridDim.x) {
            const int tn = t + gridDim.x;
            WtJob jobn = job; float nxt[8];
            if (tn < total) { jobn = wt_decode(P, tn); wt_load(jobn, nxt); }
            else {
#pragma unroll
                for (int q = 0; q < 8; ++q) nxt[q] = 0.f;
            }
            wt_store(job, cur);
            job = jobn;
#pragma unroll
            for (int q = 0; q < 8; ++q) cur[q] = nxt[q];
        }
    }
    {
        bf16_t* wgx = (bf16_t*)(P.ws + OFF_WT_GATES);
        const float* wg = P.in[I_WG];
        for (int idx = blockIdx.x * NT + TIDX; idx < 2 * 4 * 256 * 128; idx += gridDim.x * NT) {
            const int k = idx & 127, n = (idx >> 7) & 255, pr = (idx >> 15) & 3, e = idx >> 17;
            float v = 0.f;
            if (n < 128) { if (k < 64) v = wg[((size_t)(e * 8 + 2 * pr) * 64 + k) * 128 + n]; }
            else { if (k >= 64) v = wg[((size_t)(e * 8 + 2 * pr + 1) * 64 + (k - 64)) * 128 + (n - 128)]; }
            wgx[idx] = f2bf(v);
        }
        float* sacc = (float*)(P.ws + OFF_SACC);
        for (int idx = blockIdx.x * NT + TIDX; idx < 256 * 1024; idx += gridDim.x * NT) sacc[idx] = 0.f;
    }
    {
        float* rc = (float*)(P.ws + OFF_ROPE); float* rs = rc + 32768;
        for (int idx = blockIdx.x * NT + TIDX; idx < 32768; idx += gridDim.x * NT) {
            const int pos = idx >> 3, i = idx & 7;
            const float inv = powf(500000.0f, -0.125f * (float)i);
            const float ang = (float)pos * inv;
            const double x = (double)ang;
            const double k = rint(x * 0.15915494309189535);
            const float rr = (float)(x - k * 6.283185307179586);
            rc[idx] = __cosf(rr); rs[idx] = __sinf(rr);
        }
    }
}

DI void phase_norm(const Params& P, int mode, float scale, const float* __restrict__ g_post, const float* __restrict__ g_next) {
    const int lane = TIDX & 63, wave = TIDX >> 6;
    float* X = P.out + O_Y;
    bf16_t* HN = (bf16_t*)(P.ws + OFF_HN);
    const bf16_t* OUT = (const bf16_t*)(P.ws + OFF_OUT);
    for (int row = blockIdx.x * NW + wave; row < MT; row += gridDim.x * NW) {
        f32x4 xv[4];
        if (mode == 0) {
            const float* src = row < MP ? P.in[I_XP] + (size_t)row * DM : P.in[I_XS] + (size_t)(row - MP) * DM;
#pragma unroll
            for (int i = 0; i < 4; ++i) xv[i] = *(const f32x4*)(src + lane * 4 + 256 * i);
        } else {
            f32x4 ov[4], xo[4]; float ss = 0.f;
#pragma unroll
            for (int i = 0; i < 4; ++i) xo[i] = *(const f32x4*)(X + (size_t)row * DM + lane * 4 + 256 * i);
#pragma unroll
            for (int i = 0; i < 4; ++i) {
                if (row < MP) {
                    const u32x2 w = *(const u32x2*)(OUT + (size_t)row * DM + lane * 4 + 256 * i);
                    ov[i] = (f32x4){__uint_as_float(w.x << 16), __uint_as_float(w.x & 0xffff0000u), __uint_as_float(w.y << 16), __uint_as_float(w.y & 0xffff0000u)};
                } else {
                    float* sp = (float*)(P.ws + OFF_SACC) + (size_t)(row - MP) * DM + lane * 4 + 256 * i;
                    ov[i] = *(const f32x4*)sp;
                    *(f32x4*)sp = (f32x4){0.f, 0.f, 0.f, 0.f};
                }
                ss += ov[i].x * ov[i].x + ov[i].y * ov[i].y + ov[i].z * ov[i].z + ov[i].w * ov[i].w;
            }
            ss = wave_sum(ss);
            const float rstd = rsqrtf(ss * (1.0f / 1024.0f) + EPSN) * scale;
#pragma unroll
            for (int i = 0; i < 4; ++i) {
                const f32x4 gp = *(const f32x4*)(g_post + lane * 4 + 256 * i);
                xv[i] = xo[i] + ov[i] * rstd * gp;
            }
        }
#pragma unroll
        for (int i = 0; i < 4; ++i) *(f32x4*)(X + (size_t)row * DM + lane * 4 + 256 * i) = xv[i];
        if (g_next) {
            float ss = 0.f;
#pragma unroll
            for (int i = 0; i < 4; ++i) ss += xv[i].x * xv[i].x + xv[i].y * xv[i].y + xv[i].z * xv[i].z + xv[i].w * xv[i].w;
            ss = wave_sum(ss);
            const float rstd = rsqrtf(ss * (1.0f / 1024.0f) + EPSN);
#pragma unroll
            for (int i = 0; i < 4; ++i) {
                const f32x4 gn = *(const f32x4*)(g_next + lane * 4 + 256 * i);
                const f32x4 hv = xv[i] * rstd * gn;
                *(u32x2*)(HN + (size_t)row * DM + lane * 4 + 256 * i) = (u32x2){pk2(hv.x, hv.y), pk2(hv.z, hv.w)};
            }
        }
    }
}

DI void cache_prep(const float* __restrict__ ck, const float* __restrict__ cv, bf16_t* __restrict__ KS, bf16_t* __restrict__ VS_, int W) {
    const int cpr = W / 8;
    const int nch = 16 * 1024 * cpr;
    const int gsz = gridDim.x * NT;
    for (int idx0 = blockIdx.x * NT + TIDX; idx0 < 2 * nch; idx0 += 4 * gsz) {
        f32x4 a[4], bb[4]; bf16_t* d[4]; bool ok[4];
#pragma unroll
        for (int u = 0; u < 4; ++u) {
            const int idx = idx0 + u * gsz; ok[u] = idx < 2 * nch;
            const int idc = ok[u] ? idx : idx0;
            const int which = idc >= nch; const int id = which ? idc - nch : idc;
            const int c = id % cpr, rowg = id / cpr, b = rowg >> 10, k = rowg & 1023;
            const float* sp = (which ? cv : ck) + (size_t)rowg * W + c * 8;
            a[u] = *(const f32x4*)sp; bb[u] = *(const f32x4*)(sp + 4);
            d[u] = (which ? VS_ : KS) + ((size_t)(b * KVS + k)) * W + c * 8;
        }
#pragma unroll
        for (int u = 0; u < 4; ++u)
            if (ok[u]) *(u32x4*)d[u] = (u32x4){pk2(a[u].x, a[u].y), pk2(a[u].z, a[u].w), pk2(bb[u].x, bb[u].y), pk2(bb[u].z, bb[u].w)};
    }
    const int nz = 16 * 48 * cpr;
    for (int idx = blockIdx.x * NT + TIDX; idx < 2 * nz; idx += gridDim.x * NT) {
        const int which = idx >= nz; const int id = which ? idx - nz : idx;
        const int c = id % cpr, rowg = id / cpr, b = rowg / 48, k = 1040 + rowg % 48;
        bf16_t* d = (which ? VS_ : KS) + ((size_t)(b * KVS + k)) * W + c * 8;
        *(u32x4*)d = (u32x4){0u, 0u, 0u, 0u};
    }
}

struct GemmArgs { const bf16_t* A; int lda; int a_pn_stride; const bf16_t* Bt; int K; int nM, nN; int nsk, skc; };
enum { EPI_PLAIN = 0, EPI_SWIGLU, EPI_EVEN_IN, EPI_GATES, EPI_ODD_IN, EPI_SACC };

DI bool gemm_next(int it, int nM, int nN, int& pm, int& pn) {
    const int G = gridDim.x;
    if ((G & 7) == 0) {
        const int x = blockIdx.x & 7, bl = blockIdx.x >> 3, bpx = G >> 3, j = bl + it * bpx;
        const int nMx = (nM - x + 7) >> 3;
        if (j >= nMx * nN) return false;
        const int grp = j / (8 * nN), within = j % (8 * nN);
        int gsz = nMx - grp * 8; if (gsz > 8) gsz = 8;
        pn = within / gsz; pm = x + 8 * (grp * 8 + within % gsz);
        return true;
    } else {
        const int t = blockIdx.x + it * G;
        if (t >= nM * nN) return false;
        pm = t / nN; pn = t % nN; return true;
    }
}

template <int EPI, bool QUARTER = false>
DI void gemm_epilogue(const Params& P, int li, const f32x16 (&acc)[4][2], int pm, int pn, bf16_t* __restrict__ C, int ldc, int q = 0) {
    const int tid = TIDX, lane = tid & 63, wave = tid >> 6, wr = wave >> 2, wc = QUARTER ? q : (wave & 3), r = lane & 31, hh = lane >> 5;
    const int m0 = QUARTER ? pm * 256 + wave * 32 : pm * 256 + wr * 128;
    constexpr int NMT = QUARTER ? 1 : 4;
    const bool samp = pm * 256 >= MP;
    if (EPI == EPI_PLAIN) {
#pragma unroll
        for (int mt = 0; mt < 4; ++mt)
#pragma unroll
            for (int i = 0; i < 16; ++i) {
                const int row = m0 + mt * 32 + crow(i, hh);
#pragma unroll
                for (int nt = 0; nt < 2; ++nt) C[(size_t)row * ldc + pn * 256 + wc * 64 + nt * 32 + r] = f2bf(acc[mt][nt][i]);
            }
    } else if (EPI == EPI_SACC) {
        float* S = (float*)(P.ws + OFF_SACC);
#pragma unroll
        for (int mt = 0; mt < 4; ++mt)
#pragma unroll
            for (int i = 0; i < 16; ++i) {
                const int row = wr * 128 + mt * 32 + crow(i, hh);
#pragma unroll
                for (int nt = 0; nt < 2; ++nt) atomicAdd(S + (size_t)row * DM + pn * 256 + wc * 64 + nt * 32 + r, acc[mt][nt][i]);
            }
    } else if (EPI == EPI_SWIGLU) {
        const int j = pn * 128 + wc * 32 + r;
#pragma unroll
        for (int mt = 0; mt < 4; ++mt)
#pragma unroll
            for (int i = 0; i < 16; ++i) {
                const int row = m0 + mt * 32 + crow(i, hh);
                const float g = acc[mt][0][i], u = acc[mt][1][i];
                C[(size_t)row * DFF + j] = f2bf(g / (1.0f + __expf(-g)) * u);
            }
    } else if (EPI == EPI_EVEN_IN) {
        const int e = li;
        const int sec = (pn * 256) >> 9;
        const int cb0 = ((pn * 256) & 511) + wc * 64 + r;
        if (sec == 0) {
            float* U = (float*)(P.ws + R_U);
#pragma unroll
            for (int mt = 0; mt < 4; ++mt)
#pragma unroll
                for (int i = 0; i < 16; ++i) {
                    const int row = m0 + mt * 32 + crow(i, hh);
#pragma unroll
                    for (int nt = 0; nt < 2; ++nt) U[(size_t)row * 512 + cb0 + nt * 32] = acc[mt][nt][i];
                }
        } else if (sec == 1) {
            bf16_t* Gb = (bf16_t*)(P.ws + R_G);
#pragma unroll
            for (int mt = 0; mt < 4; ++mt)
#pragma unroll
                for (int i = 0; i < 16; ++i) {
                    const int row = m0 + mt * 32 + crow(i, hh);
#pragma unroll
                    for (int nt = 0; nt < 2; ++nt) Gb[(size_t)row * 512 + cb0 + nt * 32] = f2bf(gelu_tanh(acc[mt][nt][i]));
                }
        } else if (sec == 2) {
            bf16_t* QE = (bf16_t*)(P.ws + R_QE);
#pragma unroll
            for (int mt = 0; mt < 4; ++mt)
#pragma unroll
                for (int i = 0; i < 16; ++i) {
                    const int row = m0 + mt * 32 + crow(i, hh);
#pragma unroll
                    for (int nt = 0; nt < 2; ++nt) QE[(size_t)row * 512 + cb0 + nt * 32] = f2bf(acc[mt][nt][i] * (0.125f * LOG2E));
                }
        } else if (sec == 3 || sec == 4) {
            bf16_t* bb; float* ob;
            if (!samp) { bb = (bf16_t*)(P.ws + (sec == 3 ? R_KE : R_VE)); ob = P.out + (sec == 3 ? O_PFK : O_PFV) + (size_t)e * (8 * 4096 * 512); }
            else { bb = (bf16_t*)(P.ws + (sec == 3 ? OFF_KS : OFF_VS)); ob = P.out + (sec == 3 ? O_SFK : O_SFV) + (size_t)e * (16 * 16 * 512); }
#pragma unroll
            for (int mt = 0; mt < 4; ++mt)
#pragma unroll
                for (int i = 0; i < 16; ++i) {
                    const int row = m0 + mt * 32 + crow(i, hh);
                    const int mm = row - MP;
                    const size_t rb = samp ? (size_t)((mm >> 4) * KVS + 1024 + (mm & 15)) : (size_t)row;
                    const size_t ro = samp ? (size_t)mm : (size_t)row;
#pragma unroll
                    for (int nt = 0; nt < 2; ++nt) {
                        const float v = acc[mt][nt][i];
                        bb[rb * 512 + cb0 + nt * 32] = f2bf(v);
                        ob[ro * 512 + cb0 + nt * 32] = v;
                    }
                }
        } else {
            float* LF = (float*)(P.ws + R_LOGF);
            if (cb0 < 8) {
                const float bf_ = P.in[I_BFF][e * 8 + cb0];
#pragma unroll
                for (int mt = 0; mt < 4; ++mt)
#pragma unroll
                    for (int i = 0; i < 16; ++i) {
                        const int row = m0 + mt * 32 + crow(i, hh);
                        const int mm = row - MP;
                        const float lf = -softplusf_(-(acc[mt][0][i] + bf_));
                        LF[(size_t)row * 8 + cb0] = lf;
                        if (!samp) P.out[O_PFL + (size_t)e * (8 * 4096 * 8) + (size_t)row * 8 + cb0] = lf;
                        else P.out[O_SFL + (size_t)e * (16 * 16 * 8) + (size_t)mm * 8 + cb0] = lf;
                    }
            }
        }
    } else if (EPI == EPI_GATES) {
        const int e = li, blk = 2 * pn + (wc >> 1);
        float* LA = (float*)(P.ws + R_LA); float* IU = (float*)(P.ws + R_IU); const bf16_t* UC = (const bf16_t*)(P.ws + R_UC);
#pragma unroll
        for (int nt = 0; nt < 2; ++nt) {
            const int n = (wc & 1) * 64 + nt * 32 + r, ch = blk * 64 + (n & 63);
            const float bias = P.in[I_BG][(e * 8 + blk) * 128 + n];
            const float sp = softplusf_(-P.in[I_LAM][e * 512 + ch]);
#pragma unroll
            for (int mt = 0; mt < 4; ++mt)
#pragma unroll
                for (int i = 0; i < 16; ++i) {
                    const int row = m0 + mt * 32 + crow(i, hh);
                    const float sg = sigmoidf_(acc[mt][nt][i] + bias);
                    if ((wc & 1) == 0) LA[(size_t)row * 512 + ch] = -8.0f * sg * sp;
                    else IU[(size_t)row * 512 + ch] = sg * bf2f(UC[(size_t)row * 512 + ch]);
                }
        }
    } else if (EPI == EPI_ODD_IN) {
        const int o = li;
        const int sec = (pn * 256) >> 10;
        bf16_t* QO = (bf16_t*)(P.ws + R_QO); bf16_t* KO = (bf16_t*)(P.ws + R_KO); bf16_t* VO = (bf16_t*)(P.ws + R_VO);
        bf16_t* KSb = (bf16_t*)(P.ws + OFF_KS); bf16_t* VSb = (bf16_t*)(P.ws + OFF_VS);
        const float* rc = (const float*)(P.ws + OFF_ROPE); const float* rs = rc + 32768;
#pragma unroll
        for (int mt = 0; mt < NMT; ++mt)
#pragma unroll
            for (int i = 0; i < 16; ++i) {
                const int row = m0 + mt * 32 + crow(i, hh);
                const int mm = row - MP;
                const int pos = samp ? 1024 + (mm & 15) : (row & 4095);
#pragma unroll
                for (int nt = 0; nt < 2; ++nt) {
                    const int c = ((pn * 256) & 1023) + wc * 64 + nt * 32 + r;
                    float v = acc[mt][nt][i];
                    if (sec < 2 && nt == 0) {
                        const float other = __shfl_xor(v, 8);
                        const float cs = rc[pos * 8 + (r & 7)], sn = rs[pos * 8 + (r & 7)];
                        if (r < 8) v = v * cs - other * sn;
                        else if (r < 16) v = v * cs + other * sn;
                    }
                    if (sec == 0) QO[(size_t)row * 1024 + c] = f2bf(v * (0.125f * LOG2E));
                    else {
                        bf16_t* dstb; float* dsto;
                        if (!samp) {
                            dstb = (sec == 1 ? KO : VO) + (size_t)row * 1024 + c;
                            dsto = P.out + (sec == 1 ? O_PDK : O_PDV) + (size_t)o * (8 * 4096 * 1024) + (size_t)row * 1024 + c;
                        } else {
                            dstb = (sec == 1 ? KSb : VSb) + ((size_t)((mm >> 4) * KVS + 1024 + (mm & 15))) * 1024 + c;
                            dsto = P.out + (sec == 1 ? O_SDK : O_SDV) + (size_t)o * (16 * 16 * 1024) + (size_t)mm * 1024 + c;
                        }
                        *dstb = f2bf(v); *dsto = v;
                    }
                }
            }
    }
}

template <bool QUARTER>
DI void gemm_tile_loop(const bf16_t* __restrict__ Ap, int lda, const bf16_t* __restrict__ Bp, int ldb, int ks0, int nks, f32x16 (&acc)[4][2], int q = 0) {
    const int tid = TIDX, lane = tid & 63, wave = tid >> 6, wr = wave >> 2, wc = wave & 3, r = lane & 31, hh = lane >> 5;
    const int sc = tid & 7, sr = tid >> 3;
    LDS char* sm = (LDS char*)smem;
#pragma unroll
    for (int a = 0; a < 4; ++a)
#pragma unroll
        for (int b = 0; b < 2; ++b)
#pragma unroll
            for (int i = 0; i < 16; ++i) acc[a][b][i] = 0.f;
    const unsigned aoff = (unsigned)(sr * lda + sc * 8) * 2u, astep = (unsigned)(64 * lda) * 2u;
    const unsigned boff = (unsigned)(sr * ldb + sc * 8) * 2u, bstep = (unsigned)(64 * ldb) * 2u;
    const int soff = sr * 128 + ((sc ^ ((sr >> 1) & 7)) << 4);
    const char* ap = (const char*)Ap + (size_t)ks0 * 128;
    const char* bp = (const char*)Bp + (size_t)ks0 * 128;
    u32x4 r0a[4], r0b[4], r1a[4], r1b[4];
    auto gload = [&](u32x4 (&ra)[4], u32x4 (&rb)[4], int st) {
        const char* a = ap + (size_t)st * 128; const char* b = bp + (size_t)st * 128;
#pragma unroll
        for (int i = 0; i < 4; ++i) { ra[i] = *(const u32x4*)(a + aoff + i * astep); rb[i] = *(const u32x4*)(b + boff + i * bstep); }
    };
    auto swrite = [&](const u32x4 (&ra)[4], const u32x4 (&rb)[4], int buf) {
#pragma unroll
        for (int i = 0; i < 4; ++i) { *(LDS u32x4*)(sm + buf * 65536 + soff + i * 8192) = ra[i]; *(LDS u32x4*)(sm + buf * 65536 + 32768 + soff + i * 8192) = rb[i]; }
    };
    const int arow = QUARTER ? (wave * 32 + r) * 128 : (wr * 128 + r) * 128, brow = 32768 + ((QUARTER ? q : wc) * 64 + r) * 128, swz = (r >> 1) & 7;
    auto compute = [&](int buf) {
#pragma unroll
        for (int ks = 0; ks < 4; ++ks) {
            const int ch = (((ks << 1) | hh) ^ swz) << 4;
            bf16x8 af[4], bfr[2];
#pragma unroll
            for (int t = 0; t < (QUARTER ? 1 : 4); ++t) af[t] = *(LDS bf16x8*)(sm + buf * 65536 + arow + t * 4096 + ch);
#pragma unroll
            for (int t = 0; t < 2; ++t) bfr[t] = *(LDS bf16x8*)(sm + buf * 65536 + brow + t * 4096 + ch);
#pragma unroll
            for (int mt = 0; mt < (QUARTER ? 1 : 4); ++mt)
#pragma unroll
                for (int nt = 0; nt < 2; ++nt) acc[mt][nt] = MFMA(af[mt], bfr[nt], acc[mt][nt]);
        }
    };
    gload(r0a, r0b, 0);
    if (nks > 1) gload(r1a, r1b, 1);
    swrite(r0a, r0b, 0);
    __syncthreads();
    if (nks > 2) gload(r0a, r0b, 2);
    for (int kt = 0; kt < nks; kt += 2) {
        compute(0);
        if (kt + 1 < nks) swrite(r1a, r1b, 1);
        __syncthreads();
        if (kt + 3 < nks) gload(r1a, r1b, kt + 3);
        if (kt + 1 < nks) {
            compute(1);
            if (kt + 2 < nks) swrite(r0a, r0b, 0);
            __syncthreads();
            if (kt + 4 < nks) gload(r0a, r0b, kt + 4);
        }
    }
}

template <int EPI>
DI void gemm_phase(const Params& P, int li, const GemmArgs g, bf16_t* __restrict__ C, int ldc) {
    int pm, pn, it = 0;
    for (; gemm_next(it, g.nM, g.nN, pm, pn); ++it) {
        const bf16_t* Ap = g.A + (size_t)(pm * 256) * g.lda + (size_t)pn * g.a_pn_stride;
        const bf16_t* Bp = g.Bt + (size_t)(pn * 256) * g.K;
        f32x16 acc[4][2];
        gemm_tile_loop<false>(Ap, g.lda, Bp, g.K, 0, g.K >> 6, acc);
        gemm_epilogue<EPI>(P, li, acc, pm, pn, C, ldc);
        if (EPI == EPI_GATES) {
            __syncthreads();
            const float* LA = (const float*)(P.ws + R_LA); const float* IU = (const float*)(P.ws + R_IU);
            float* SA = (float*)(P.ws + R_SEGA); float* SB = (float*)(P.ws + R_SEGB);
            const bool smp = pm == 128;
            const int nit = (smp ? 16 : 4) * 128, len = smp ? 16 : 64;
            for (int item = TIDX; item < nit; item += NT) {
                const int sl = item >> 7, ch = pn * 128 + (item & 127);
                const int seg = smp ? 512 + sl : pm * 4 + sl, row0 = smp ? MP + sl * 16 : pm * 256 + sl * 64;
                float h = 0.f, p = 1.f;
                for (int j0 = 0; j0 < len; j0 += 8) {
                    float la[8], iu[8];
#pragma unroll
                    for (int j = 0; j < 8; ++j) { la[j] = LA[(size_t)(row0 + j0 + j) * 512 + ch]; iu[j] = IU[(size_t)(row0 + j0 + j) * 512 + ch]; }
#pragma unroll
                    for (int j = 0; j < 8; ++j) {
                        const float a = __expf(la[j]), bx = sqrtf(-expm1f(2.0f * la[j])) * iu[j];
                        h = a * h + bx; p *= a;
                    }
                }
                SA[seg * 512 + ch] = p; SB[seg * 512 + ch] = h;
            }
        }
    }
    if (EPI == EPI_SWIGLU) {
        const int tid = TIDX, lane = tid & 63, wave = tid >> 6, r = lane & 31, hh = lane >> 5;
        for (int j = (int)gridDim.x - 1 - (int)blockIdx.x; j < g.nsk; j += gridDim.x) {
            const int pn2 = j >> 2, q = j & 3;
            const bf16_t* Ap = g.A + (size_t)MP * g.lda;
            const bf16_t* Bp = g.Bt + (size_t)(pn2 * 256) * g.K;
            f32x16 acc[4][2];
            gemm_tile_loop<true>(Ap, g.lda, Bp, g.K, 0, g.K >> 6, acc, q);
            const int jc = pn2 * 128 + q * 32 + r;
#pragma unroll
            for (int i = 0; i < 16; ++i) {
                const int row = MP + wave * 32 + crow(i, hh);
                const float gv = acc[0][0][i], uv = acc[0][1][i];
                C[(size_t)row * DFF + jc] = f2bf(gv / (1.0f + __expf(-gv)) * uv);
            }
        }
    }
    if (EPI == EPI_ODD_IN) {
        for (int j = (int)gridDim.x - 1 - (int)blockIdx.x; j < g.nsk; j += gridDim.x) {
            const int pn2 = j >> 2, q = j & 3;
            const bf16_t* Ap = g.A + (size_t)MP * g.lda;
            const bf16_t* Bp = g.Bt + (size_t)(pn2 * 256) * g.K;
            f32x16 acc[4][2];
            gemm_tile_loop<true>(Ap, g.lda, Bp, g.K, 0, g.K >> 6, acc, q);
            gemm_epilogue<EPI_ODD_IN, true>(P, li, acc, 128, pn2, nullptr, 0, q);
        }
    }
    if (EPI == EPI_PLAIN) {
        for (int j = (int)gridDim.x - 1 - (int)blockIdx.x; j < g.nsk; j += gridDim.x) {
            const int pn2 = j % g.nN, kc = j / g.nN;
            const bf16_t* Ap = g.A + (size_t)MP * g.lda;
            const bf16_t* Bp = g.Bt + (size_t)(pn2 * 256) * g.K;
            f32x16 acc[4][2];
            gemm_tile_loop<false>(Ap, g.lda, Bp, g.K, kc * g.skc, g.skc, acc);
            gemm_epilogue<EPI_SACC>(P, li, acc, 128, pn2, nullptr, 0);
        }
    }
}

DI void phase_conv(const Params& P, int e) {
    const float* __restrict__ U = (const float*)(P.ws + R_U);
    bf16_t* __restrict__ UC = (bf16_t*)(P.ws + R_UC);
    const float* cw = P.in[I_CW] + e * 4 * 512; const float* cbias = P.in[I_CB] + e * 512;
    const float* sbuf = P.in[I_SLC] + (size_t)e * 16 * 3 * 512;
    const int gtid = blockIdx.x * NT + TIDX, gsz = gridDim.x * NT;
    for (int idx = gtid; idx < MT * 128; idx += gsz) {
        const int row = idx >> 7, c = (idx & 127) * 4;
        int t, b; const bool samp = row >= MP;
        if (!samp) { t = row & 4095; b = row >> 12; } else { t = (row - MP) & 15; b = (row - MP) >> 4; }
        f32x4 acc = *(const f32x4*)(cbias + c);
#pragma unroll
        for (int j = 0; j < 4; ++j) {
            const int tt = t - 3 + j;
            f32x4 uv;
            if (tt >= 0) uv = *(const f32x4*)(U + (size_t)(row - 3 + j) * 512 + c);
            else if (samp) uv = *(const f32x4*)(sbuf + ((size_t)b * 3 + (3 + tt)) * 512 + c);
            else uv = (f32x4){0.f, 0.f, 0.f, 0.f};
            acc += uv * *(const f32x4*)(cw + j * 512 + c);
        }
        *(u32x2*)(UC + (size_t)row * 512 + c) = (u32x2){pk2(acc.x, acc.y), pk2(acc.z, acc.w)};
    }
    for (int idx = gtid; idx < (8 + 16) * 3 * 512; idx += gsz) {
        const int c = idx & 511, i = (idx >> 9) % 3, s = idx / 1536;
        if (s < 8) P.out[O_PLC + ((size_t)(e * 8 + s) * 3 + i) * 512 + c] = U[(size_t)(s * 4096 + 4093 + i) * 512 + c];
        else P.out[O_SLC + ((size_t)(e * 16 + (s - 8)) * 3 + i) * 512 + c] = U[(size_t)(MP + (s - 8) * 16 + 13 + i) * 512 + c];
    }
    const float* LF = (const float*)(P.ws + R_LOGF);
    float* CBP = (float*)(P.ws + R_CBP); float* CBS = (float*)(P.ws + R_CBS);
    const int lane = TIDX & 63;
    for (int w = blockIdx.x * NW + (TIDX >> 6); w < 64 + 128; w += gridDim.x * NW) {
        if (w < 64) {
            const int s = w >> 3, h = w & 7;
            float loc = 0.f;
            for (int j0 = 0; j0 < 64; j0 += 16) {
                float v[16];
#pragma unroll
                for (int j = 0; j < 16; ++j) v[j] = LF[(size_t)(s * 4096 + lane * 64 + j0 + j) * 8 + h];
#pragma unroll
                for (int j = 0; j < 16; ++j) loc += v[j];
            }
            float inc = loc;
#pragma unroll
            for (int o = 1; o < 64; o <<= 1) { const float t = __shfl_up(inc, o); if (lane >= o) inc += t; }
            float run = inc - loc;
            for (int j0 = 0; j0 < 64; j0 += 16) {
                float v[16];
#pragma unroll
                for (int j = 0; j < 16; ++j) v[j] = LF[(size_t)(s * 4096 + lane * 64 + j0 + j) * 8 + h];
#pragma unroll
                for (int j = 0; j < 16; ++j) { run += v[j]; v[j] = -run * LOG2E; }
#pragma unroll
                for (int j = 0; j < 16; ++j) CBP[(size_t)(s * 8 + h) * 4096 + lane * 64 + j0 + j] = v[j];
            }
        } else {
            const int b = (w - 64) >> 3, h = (w - 64) & 7;
            const float* cl = P.in[I_CFL] + (size_t)(e * 16 + b) * 1024 * 8;
            float loc = 0.f;
            for (int j = 0; j < 17; ++j) {
                const int k = lane * 17 + j;
                float v = 0.f;
                if (k < 1024) v = cl[(size_t)k * 8 + h]; else if (k < 1040) v = LF[(size_t)(MP + b * 16 + (k - 1024)) * 8 + h];
                loc += v;
            }
            float inc = loc;
#pragma unroll
            for (int o = 1; o < 64; o <<= 1) { const float t = __shfl_up(inc, o); if (lane >= o) inc += t; }
            float run = inc - loc;
            for (int j = 0; j < 17; ++j) {
                const int k = lane * 17 + j;
                float v = 0.f;
                if (k < 1024) v = cl[(size_t)k * 8 + h]; else if (k < 1040) v = LF[(size_t)(MP + b * 16 + (k - 1024)) * 8 + h];
                run += v;
                CBS[(size_t)(b * 8 + h) * KVS + k] = -run * LOG2E;
            }
        }
    }
}

DI void seg_info(int seg, int& row0, int& len) { if (seg < 512) { row0 = seg * 64; len = 64; } else { row0 = MP + (seg - 512) * 16; len = 16; } }

DI void phase_scan1(const Params& P) {
    const float* LA = (const float*)(P.ws + R_LA); const float* IU = (const float*)(P.ws + R_IU);
    float* SA = (float*)(P.ws + R_SEGA); float* SB = (float*)(P.ws + R_SEGB);
    for (int idx = blockIdx.x * NT + TIDX; idx < 528 * 512; idx += gridDim.x * NT) {
        const int seg = idx >> 9, c = idx & 511;
        int row0, len; seg_info(seg, row0, len);
        float h = 0.f, p = 1.f;
        for (int j0 = 0; j0 < len; j0 += 8) {
            float la[8], iu[8];
#pragma unroll
            for (int j = 0; j < 8; ++j) { la[j] = LA[(size_t)(row0 + j0 + j) * 512 + c]; iu[j] = IU[(size_t)(row0 + j0 + j) * 512 + c]; }
#pragma unroll
            for (int j = 0; j < 8; ++j) {
                const float a = __expf(la[j]), bx = sqrtf(-expm1f(2.0f * la[j])) * iu[j];
                h = a * h + bx; p *= a;
            }
        }
        SA[idx] = p; SB[idx] = h;
    }
}

DI void phase_scan3(const Params& P, int e) {
    const float* LA = (const float*)(P.ws + R_LA); const float* IU = (const float*)(P.ws + R_IU);
    const float* SA = (const float*)(P.ws + R_SEGA); const float* SB = (const float*)(P.ws + R_SEGB);
    const bf16_t* Gb = (const bf16_t*)(P.ws + R_G);
    bf16_t* MIX = (bf16_t*)(P.ws + OFF_HN);
    for (int idx = blockIdx.x * NT + TIDX; idx < 528 * 512; idx += gridDim.x * NT) {
        const int seg = idx >> 9, c = idx & 511;
        int row0, len; seg_info(seg, row0, len);
        float h = 0.f;
        if (seg < 512) {
            const int s0 = seg & ~63;
            for (int sb = s0; sb < seg; sb += 8) {
                float sa[8], sbv[8];
#pragma unroll
                for (int j = 0; j < 8; ++j) { const int sj = (sb + j < seg) ? sb + j : s0; sa[j] = SA[sj * 512 + c]; sbv[j] = SB[sj * 512 + c]; }
#pragma unroll
                for (int j = 0; j < 8; ++j) if (sb + j < seg) h = sa[j] * h + sbv[j];
            }
        }
        else h = P.in[I_SLH][(size_t)(e * 16 + (seg - 512)) * 512 + c];
        for (int j0 = 0; j0 < len; j0 += 8) {
            float la[8], iu[8], gg[8], y[8];
#pragma unroll
            for (int j = 0; j < 8; ++j) {
                la[j] = LA[(size_t)(row0 + j0 + j) * 512 + c]; iu[j] = IU[(size_t)(row0 + j0 + j) * 512 + c];
                gg[j] = bf2f(Gb[(size_t)(row0 + j0 + j) * 512 + c]);
            }
#pragma unroll
            for (int j = 0; j < 8; ++j) {
                const float a = __expf(la[j]), bx = sqrtf(-expm1f(2.0f * la[j])) * iu[j];
                h = a * h + bx; y[j] = h * gg[j];
            }
#pragma unroll
            for (int j = 0; j < 8; ++j) MIX[(size_t)(row0 + j0 + j) * 1024 + c] = f2bf(y[j]);
        }
        if (seg < 512) { if ((seg & 63) == 63) P.out[O_PLH + (size_t)(e * 8 + (seg >> 6)) * 512 + c] = h; }
        else P.out[O_SLH + (size_t)(e * 16 + (seg - 512)) * 512 + c] = h;
    }
}

template <int DV, bool BIAS>
DI void flash_pass(const bf16_t* __restrict__ Qb, int ldq, const bf16_t* __restrict__ Kb, int ldk, const bf16_t* __restrict__ Vb, int ldv,
                   const float* __restrict__ cb, int q0, int nq, int past, int mode, int kvlen, f32x16 (&O)[DV / 32], float& l_out) {
    constexpr int VSTR = (DV == 64) ? 192 : 320;
    constexpr int BUFSZ = 8192 + 64 * VSTR + 256;
    constexpr int VCH = DV / 8, NVL = (64 * VCH) / NT;
    const int tid = TIDX, lane = tid & 63, wave = tid >> 6, r = lane & 31, hh = lane >> 5;
    LDS char* sm = (LDS char*)smem;
    const int qw0 = q0 + wave * 32;
    const bool wactive = qw0 < nq;
    int qi = qw0 + r; if (qi > nq - 1) qi = nq - 1;
    const int qabs = past + qi;
    int klim = qabs; if (mode == 1) { klim = qabs | 63; if (klim > kvlen - 1) klim = kvlen - 1; }
    int qlw = qw0 + 31; if (qlw > nq - 1) qlw = nq - 1;
    int wkmax = past + qlw; if (mode == 1) { wkmax |= 63; if (wkmax > kvlen - 1) wkmax = kvlen - 1; }
    const int wkmin = (mode == 0) ? past + qw0 : wkmax;
    int qlb = q0 + NW * 32 - 1; if (qlb > nq - 1) qlb = nq - 1;
    int bkmax = past + qlb; if (mode == 1) { bkmax |= 63; if (bkmax > kvlen - 1) bkmax = kvlen - 1; }
    const int ntiles = (bkmax >> 6) + 1;

    bf16x8 qf[4];
#pragma unroll
    for (int ks = 0; ks < 4; ++ks) qf[ks] = *(const bf16x8*)(Qb + (size_t)qi * ldq + ks * 16 + hh * 8);
#pragma unroll
    for (int dt = 0; dt < DV / 32; ++dt)
#pragma unroll
        for (int i = 0; i < 16; ++i) O[dt][i] = 0.f;
    float m = -1e30f, l = 0.f;

    u32x4 rk[1], rv[NVL]; f32x4 rc4 = {0.f, 0.f, 0.f, 0.f};
    unsigned koff[1], vofs[NVL];
#pragma unroll
    for (int i = 0; i < 1; ++i) { const int idx = tid + NT * i, row = idx >> 3, c = idx & 7; koff[i] = (unsigned)(row * ldk + c * 8) * 2u; }
#pragma unroll
    for (int i = 0; i < NVL; ++i) { const int idx = tid + NT * i, row = idx / VCH, c = idx % VCH; vofs[i] = (unsigned)(row * ldv + c * 8) * 2u; }
    auto prefetch = [&](int kt) {
        const char* kp = (const char*)Kb + (size_t)kt * 128 * ldk;
        const char* vp = (const char*)Vb + (size_t)kt * 128 * ldv;
#pragma unroll
        for (int i = 0; i < 1; ++i) rk[i] = *(const u32x4*)(kp + koff[i]);
        if (DV == 64) {
#pragma unroll
            for (int i = 0; i < NVL; ++i) rv[i] = *(const u32x4*)(vp + vofs[i]);
        }
        if (BIAS) { if (tid < 16) rc4 = *(const f32x4*)(cb + kt * 64 + tid * 4); }
    };
    auto late_v = [&](int kt) {
        if (DV != 64) {
            const char* vp = (const char*)Vb + (size_t)kt * 128 * ldv;
#pragma unroll
            for (int i = 0; i < NVL; ++i) rv[i] = *(const u32x4*)(vp + vofs[i]);
        }
    };
    auto stash = [&](int buf) {
        LDS char* b = sm + buf * BUFSZ;
#pragma unroll
        for (int i = 0; i < 1; ++i) { const int idx = tid + NT * i, row = idx >> 3, c = idx & 7; *(LDS u32x4*)(b + row * 128 + ((c ^ ((row >> 1) & 7)) << 4)) = rk[i]; }
#pragma unroll
        for (int i = 0; i < NVL; ++i) { const int idx = tid + NT * i, row = idx / VCH, c = idx % VCH; *(LDS u32x4*)(b + 8192 + row * VSTR + c * 16) = rv[i]; }
        if (BIAS) { if (tid < 16) *(LDS f32x4*)(b + 8192 + 64 * VSTR + tid * 16) = rc4; }
    };
    prefetch(0); late_v(0); stash(0); __syncthreads();
    const int q4 = (lane & 15) >> 2, p4 = lane & 3, g1 = (lane >> 4) & 1;
    const int voff = (4 * hh + q4) * VSTR + (16 * g1 + 4 * p4) * 2;
    for (int kt = 0; kt < ntiles; ++kt) {
        if (kt + 1 < ntiles) prefetch(kt + 1);
        if (wactive && kt * 64 <= wkmax) {
            LDS char* kb = sm + (kt & 1) * BUFSZ; LDS char* vb = kb + 8192; LDS char* cbp = vb + 64 * VSTR;
            const bool need_mask = kt * 64 + 63 > wkmin;
#pragma unroll
            for (int st = 0; st < 2; ++st) {
                asm volatile("" ::: "memory");
                f32x16 S;
#pragma unroll
                for (int i = 0; i < 16; ++i) S[i] = 0.f;
#pragma unroll
                for (int ks = 0; ks < 4; ++ks) {
                    const bf16x8 a = *(LDS bf16x8*)(kb + (st * 32 + r) * 128 + ((((ks << 1) | hh) ^ ((r >> 1) & 7)) << 4));
                    S = MFMA(a, qf[ks], S);
                }
                if (BIAS) {
#pragma unroll
                    for (int g = 0; g < 4; ++g) {
                        const f32x4 c4 = *(LDS f32x4*)(cbp + (st * 32 + 8 * g + 4 * hh) * 4);
                        S[4 * g + 0] += c4.x; S[4 * g + 1] += c4.y; S[4 * g + 2] += c4.z; S[4 * g + 3] += c4.w;
                    }
                }
                if (need_mask) {
#pragma unroll
                    for (int i = 0; i < 16; ++i) { const int key = kt * 64 + st * 32 + crow(i, hh); if (key > klim) S[i] = -1e30f; }
                }
                float mx = S[0];
#pragma unroll
                for (int i = 1; i < 16; ++i) mx = fmaxf(mx, S[i]);
                mx = fmaxf(mx, __shfl_xor(mx, 32));
                if (__any(mx > m)) {
                    const float mn = fmaxf(m, mx);
                    const float alpha = __builtin_amdgcn_exp2f(m - mn);
                    m = mn; l *= alpha;
#pragma unroll
                    for (int dt = 0; dt < DV / 32; ++dt)
#pragma unroll
                        for (int i = 0; i < 16; ++i) O[dt][i] *= alpha;
                }
                float ps = 0.f;
#pragma unroll
                for (int i = 0; i < 16; ++i) { const float p = __builtin_amdgcn_exp2f(S[i] - m); S[i] = p; ps += p; }
                l += ps;
                bf16x8 pf[2];
#pragma unroll
                for (int s = 0; s < 2; ++s) {
                    const u32x4 w = {pk2(S[8 * s + 0], S[8 * s + 1]), pk2(S[8 * s + 2], S[8 * s + 3]), pk2(S[8 * s + 4], S[8 * s + 5]), pk2(S[8 * s + 6], S[8 * s + 7])};
                    pf[s] = __builtin_bit_cast(bf16x8, w);
                }
#pragma unroll
                for (int dt = 0; dt < DV / 32; ++dt) {
                    if (DV > 64) asm volatile("" ::: "memory");
#pragma unroll
                    for (int s = 0; s < 2; ++s) {
                        const s16x4 lo = __builtin_amdgcn_ds_read_tr16_b64_v4i16((LDS s16x4*)(vb + voff + (st * 32 + s * 16) * VSTR + dt * 64));
                        const s16x4 hi = __builtin_amdgcn_ds_read_tr16_b64_v4i16((LDS s16x4*)(vb + voff + (st * 32 + s * 16 + 8) * VSTR + dt * 64));
                        const bf16x8 a = __builtin_shufflevector(lo, hi, 0, 1, 2, 3, 4, 5, 6, 7);
                        O[dt] = MFMA(a, pf[s], O[dt]);
                    }
                }
            }
        }
        if (kt + 1 < ntiles) { late_v(kt + 1); stash((kt + 1) & 1); }
        __syncthreads();
    }
    l_out = l + __shfl_xor(l, 32);
}

DI int next_unit(unsigned* ctr) {
    LDS int* su = (LDS int*)((LDS char*)smem + 65528);
    if (TIDX == 0) *su = (int)atomicAdd(ctr, 1u);
    __syncthreads();
    const int u = *su;
    __syncthreads();
    return u;
}

DI int attn_unit(unsigned* ctr, int iter) {
    if (gridDim.x == 256) {
        if (iter < 4) {
            const int g = blockIdx.x >> 6, sh = blockIdx.x & 63;
            const int qb = (iter == 0) ? 15 - g : (iter == 1) ? 8 + g : (iter == 2) ? 7 - g : g;
            return 128 + (15 - qb) * 64 + sh;
        }
        const int u = next_unit(ctr);
        return u < 128 ? u : -1;
    }
    const int u = next_unit(ctr);
    return u < 128 + 1024 ? u : -1;
}

DI void unit_decode(int u, int& samp, int& s, int& h, int& qb) {
    if (u < 128) { samp = 1; s = u >> 3; h = u & 7; qb = 0; }
    else { const int v = u - 128; samp = 0; qb = 15 - (v >> 6); s = (v & 63) >> 3; h = v & 7; }
}

DI void phase_fox_attn(const Params& P, unsigned* ctr) {
    const bf16_t* QE = (const bf16_t*)(P.ws + R_QE);
    bf16_t* MIX = (bf16_t*)(P.ws + OFF_HN);
    const int lane = TIDX & 63, wave = TIDX >> 6, r = lane & 31, hh = lane >> 5;
    for (int iter = 0;; ++iter) {
        const int u = attn_unit(ctr, iter);
        if (u < 0) break;
        int samp, s, h, qb; unit_decode(u, samp, s, h, qb);
        const bf16_t *Qb, *Kb, *Vb; const float* cb; int nq, past, kvlen, row0;
        if (!samp) {
            row0 = s * 4096; nq = 4096; past = 0; kvlen = 4096;
            Kb = (const bf16_t*)(P.ws + R_KE) + (size_t)row0 * 512 + h * 64; Vb = (const bf16_t*)(P.ws + R_VE) + (size_t)row0 * 512 + h * 64;
            cb = (const float*)(P.ws + R_CBP) + (size_t)(s * 8 + h) * 4096;
        } else {
            row0 = MP + s * 16; nq = 16; past = 1024; kvlen = 1040;
            Kb = (const bf16_t*)(P.ws + OFF_KS) + (size_t)s * KVS * 512 + h * 64; Vb = (const bf16_t*)(P.ws + OFF_VS) + (size_t)s * KVS * 512 + h * 64;
            cb = (const float*)(P.ws + R_CBS) + (size_t)(s * 8 + h) * KVS;
        }
        Qb = QE + (size_t)row0 * 512 + h * 64;
        f32x16 O[2]; float l;
        flash_pass<64, true>(Qb, 512, Kb, 512, Vb, 512, cb, qb * 256, nq, past, 0, kvlen, O, l);
        const int qi = qb * 256 + wave * 32 + r;
        if (qi < nq) {
            const float inv = 1.0f / l;
            bf16_t* dst = MIX + (size_t)(row0 + qi) * 1024 + 512 + h * 64;
#pragma unroll
            for (int dt = 0; dt < 2; ++dt)
#pragma unroll
                for (int g = 0; g < 4; ++g)
                    *(u32x2*)(dst + dt * 32 + 8 * g + 4 * hh) = (u32x2){pk2(O[dt][4 * g] * inv, O[dt][4 * g + 1] * inv), pk2(O[dt][4 * g + 2] * inv, O[dt][4 * g + 3] * inv)};
        }
    }
}

DI void phase_diff_attn(const Params& P, int o, int layer, unsigned* ctr) {
    const bf16_t* QO = (const bf16_t*)(P.ws + R_QO);
    float* O1 = (float*)(P.ws + R_O1);
    bf16_t* MIX = (bf16_t*)(P.ws + OFF_HN);
    const int lane = TIDX & 63, wave = TIDX >> 6, r = lane & 31, hh = lane >> 5;
    const float lam_init = 0.8f - 0.6f * expf(-0.3f * (float)layer);
    const float* lp = P.in[I_DLAM] + o * 256;
    const float s1 = wave_sum(lp[lane] * lp[64 + lane]), s2 = wave_sum(lp[128 + lane] * lp[192 + lane]);
    const float lam = expf(s1) - expf(s2) + lam_init;
    const float* sg = P.in[I_SUBG] + o * 128;
    for (int iter = 0;; ++iter) {
        const int u = attn_unit(ctr, iter);
        if (u < 0) break;
        int samp, s, h, qb; unit_decode(u, samp, s, h, qb);
        const bf16_t *Kb, *Vb; int nq, past, kvlen, row0;
        if (!samp) {
            row0 = s * 4096; nq = 4096; past = 0; kvlen = 4096;
            Kb = (const bf16_t*)(P.ws + R_KO) + (size_t)row0 * 1024 + h * 128; Vb = (const bf16_t*)(P.ws + R_VO) + (size_t)row0 * 1024 + h * 128;
        } else {
            row0 = MP + s * 16; nq = 16; past = 1024; kvlen = 1040;
            Kb = (const bf16_t*)(P.ws + OFF_KS) + (size_t)s * KVS * 1024 + h * 128; Vb = (const bf16_t*)(P.ws + OFF_VS) + (size_t)s * KVS * 1024 + h * 128;
        }
        const bf16_t* Qb = QO + (size_t)row0 * 1024 + h * 128;
        const int qi = qb * 256 + wave * 32 + r;
        const unsigned rowc = (unsigned)(row0 + (qi < nq ? qi : nq - 1));
        const unsigned o1off = (rowc * 1024u + (unsigned)(h * 128 + 4 * hh)) * 4u;
        const unsigned mixoff = (rowc * 1024u + (unsigned)(h * 128 + 4 * hh)) * 2u;
        for (int c = 0; c < 2; ++c) {
            f32x16 O[4]; float l;
            flash_pass<128, false>(Qb + c * 64, 1024, Kb + c * 64, 1024, Vb, 1024, nullptr, qb * 256, nq, past, 1, kvlen, O, l);
            if (qi < nq) {
                const float inv = 1.0f / l;
                char* o1p = (char*)O1 + o1off;
                if (c == 0) {
#pragma unroll
                    for (int dt = 0; dt < 4; ++dt)
#pragma unroll
                        for (int g = 0; g < 4; ++g)
                            *(f32x4*)(o1p + (dt * 32 + 8 * g) * 4) = (f32x4){O[dt][4 * g] * inv, O[dt][4 * g + 1] * inv, O[dt][4 * g + 2] * inv, O[dt][4 * g + 3] * inv};
                } else {
                    float ss = 0.f;
                    const float nl = -lam * inv;
#pragma unroll
                    for (int dt = 0; dt < 4; ++dt)
#pragma unroll
                        for (int i = 0; i < 16; ++i) O[dt][i] *= nl;
#pragma unroll
                    for (int dt = 0; dt < 4; ++dt) {
#pragma unroll
                        for (int g = 0; g < 4; ++g) {
                            const f32x4 a = *(const f32x4*)(o1p + (dt * 32 + 8 * g) * 4);
#pragma unroll
                            for (int j = 0; j < 4; ++j) { const float v = a[j] + O[dt][4 * g + j]; O[dt][4 * g + j] = v; ss += v * v; }
                        }
                        asm volatile("" : "+v"(ss) :: "memory");
                    }
                    ss += __shfl_xor(ss, 32);
                    const float rstd = rsqrtf(ss * (1.0f / 128.0f) + EPSN) * (1.0f - lam_init);
                    char* dst = (char*)MIX + mixoff;
                    const char* sgp = (const char*)sg + hh * 16;
#pragma unroll
                    for (int dt = 0; dt < 4; ++dt) {
                        asm volatile("" ::: "memory");
#pragma unroll
                        for (int g = 0; g < 4; ++g) {
                            const f32x4 gg = *(const f32x4*)(sgp + (dt * 32 + 8 * g) * 4);
                            *(u32x2*)(dst + (dt * 32 + 8 * g) * 2) = (u32x2){pk2(O[dt][4 * g] * rstd * gg.x, O[dt][4 * g + 1] * rstd * gg.y), pk2(O[dt][4 * g + 2] * rstd * gg.z, O[dt][4 * g + 3] * rstd * gg.w)};
                        }
                        asm volatile("" ::: "memory");
                    }
                }
            }
        }
    }
}


#define XB_TMO      128
#define XB_XCNT(j)  (256  + 64 * (j))
#define XB_XSUB(j)  (1280 + 64 * (j))
#define XB_XGEN(j)  (2304 + 64 * (j))
#define XB_TOP      3328
#define XB_TOPGEN   3392
#define XCD_BAR_WORDS 3456
#define XB_SPIN_CAP (1u << 22)
DI unsigned xb_ld(unsigned* p) { return __hip_atomic_load(p, __ATOMIC_RELAXED, __HIP_MEMORY_SCOPE_AGENT); }
DI unsigned xb_add(unsigned* p, unsigned v) { return __hip_atomic_fetch_add(p, v, __ATOMIC_RELAXED, __HIP_MEMORY_SCOPE_AGENT); }
DI unsigned xb_xcc_id() { return (unsigned)__builtin_amdgcn_s_getreg((3 << 11) | 20) & 0xFu; }
#define XB_SPIN(cond, bar) do { unsigned _sp = 0; while (cond) { __builtin_amdgcn_s_sleep(1); \
    if ((++_sp & 255u) == 0u) { if (xb_ld(&(bar)[XB_TMO])) break; if (_sp > XB_SPIN_CAP) { atomicAdd(&(bar)[XB_TMO], 1u); break; } } } } while (0)
__shared__ __attribute__((aligned(16))) unsigned xb_words[4];
struct XcdBarrier { unsigned* bar; unsigned x; };
DI XcdBarrier xcd_barrier_post(unsigned* bar) {
    XcdBarrier b; b.bar = bar; b.x = xb_xcc_id();
    if (threadIdx.x == 0) (void)xb_add(&bar[XB_XCNT(b.x)], 1u);
    return b;
}
DI void xcd_barrier_complete(unsigned* bar, unsigned x, unsigned& nloc, unsigned& nx) {
    const unsigned G = gridDim.x * gridDim.y * gridDim.z;
    unsigned sum, cnt, mine, sp = 0u;
    for (;;) {
        sum = 0u; cnt = 0u; mine = 0u;
#pragma unroll
        for (unsigned j = 0; j < 16; ++j) { const unsigned c = xb_ld(&bar[XB_XCNT(j)]); sum += c; cnt += (c > 0u) ? 1u : 0u; mine = (j == x) ? c : mine; }
        if (sum == G) break;
        __builtin_amdgcn_s_sleep(1);
        if ((++sp & 255u) == 0u) { if (xb_ld(&bar[XB_TMO])) break; if (sp > XB_SPIN_CAP) { atomicAdd(&bar[XB_TMO], 1u); break; } }
    }
    nloc = mine > 0u ? mine : 1u; nx = cnt > 0u ? cnt : 1u;
}
DI void xcd_barrier(const XcdBarrier& b) {
    volatile LDS unsigned* st = (volatile LDS unsigned*)xb_words;
    asm volatile("s_waitcnt vmcnt(0)" ::: "memory");
    __syncthreads();
    if (threadIdx.x == 0) {
        unsigned* bar = b.bar;
        __builtin_amdgcn_s_waitcnt(0);
        unsigned nloc = st[0], nx = st[1];
        if (nloc == 0u) { xcd_barrier_complete(bar, b.x, nloc, nx); st[0] = nloc; st[1] = nx; }
        const unsigned old = xb_add(&bar[XB_XSUB(b.x)], 1u);
        const unsigned gen = old / nloc;
        if (old + 1u == (gen + 1u) * nloc) {
            __builtin_amdgcn_fence(__ATOMIC_RELEASE, "agent");
            asm volatile("s_waitcnt vmcnt(0)" ::: "memory");
            const unsigned og = xb_add(&bar[XB_TOP], 1u);
            const unsigned tg = og / nx;
            if (og + 1u == (tg + 1u) * nx) xb_add(&bar[XB_TOPGEN], 1u);
            else XB_SPIN(xb_ld(&bar[XB_TOPGEN]) == tg, bar);
            __builtin_amdgcn_fence(__ATOMIC_ACQUIRE, "agent");
            xb_add(&bar[XB_XGEN(b.x)], 1u);
            asm volatile("s_waitcnt vmcnt(0)" ::: "memory");
        } else {
            XB_SPIN(xb_ld(&bar[XB_XGEN(b.x)]) == gen, bar);
            __builtin_amdgcn_fence(__ATOMIC_ACQUIRE, "agent");
            asm volatile("s_waitcnt vmcnt(0)" ::: "memory");
        }
    }
    __syncthreads();
}

constexpr int NPHASE = 45;
DI void run_phase(const Params& P, int ph) {
    unsigned* ctrl = (unsigned*)(P.ws + OFF_CTRL);
    if (ph == 0) {
        phase_prologue(P);
        phase_norm(P, 0, 0.f, nullptr, P.in[I_NG]);
        return;
    }
    int q = ph - 1, l, st;
    if (q < 12) { l = 0; st = q; } else if (q < 22) { l = 1; st = q - 12; } else if (q < 34) { l = 2; st = q - 22; } else { l = 3; st = q - 34; }
    const bool even = (l & 1) == 0; const int li = l >> 1;
    const float* ng = P.in[I_NG] + (size_t)l * 6 * DM;
    const bf16_t* HN = (const bf16_t*)(P.ws + OFF_HN);
    bf16_t* OUT = (bf16_t*)(P.ws + OFF_OUT);
    bf16_t* ACT = (bf16_t*)(P.ws + R_ACT);
    const bf16_t* wfi = (const bf16_t*)(P.ws + OFF_WT_FFN_IN); const bf16_t* wfo = (const bf16_t*)(P.ws + OFF_WT_FFN_OUT);
    const int nst = even ? 12 : 10;
    if (st == 0 || st == nst - 3) {
        const int f = (st == 0) ? 0 : 1;
        GemmArgs g{HN, DM, 0, wfi + (size_t)(l * 2 + f) * 5632 * 1024, 1024, 128, 22, 88, 0};
        gemm_phase<EPI_SWIGLU>(P, 0, g, ACT, DFF);
    } else if (st == 1 || st == nst - 2) {
        const int f = (st == 1) ? 0 : 1;
        GemmArgs g{ACT, DFF, 0, wfo + (size_t)(l * 2 + f) * 1024 * DFF, DFF, 128, 4, 88, 2};
        gemm_phase<EPI_PLAIN>(P, 0, g, OUT, DM);
    } else if (st == 2) {
        phase_norm(P, 1, 0.5f, ng + 1 * DM, ng + 2 * DM);
        if (even) cache_prep(P.in[I_CFK] + (size_t)li * 16 * 1024 * 512, P.in[I_CFV] + (size_t)li * 16 * 1024 * 512, (bf16_t*)(P.ws + OFF_KS), (bf16_t*)(P.ws + OFF_VS), 512);
        else cache_prep(P.in[I_CDK] + (size_t)li * 16 * 1024 * 1024, P.in[I_CDV] + (size_t)li * 16 * 1024 * 1024, (bf16_t*)(P.ws + OFF_KS), (bf16_t*)(P.ws + OFF_VS), 1024);
    } else if (st == nst - 1) {
        phase_norm(P, 1, 0.5f, ng + 5 * DM, (l < 3) ? ng + 6 * DM : nullptr);
    } else if (st == nst - 4) {
        phase_norm(P, 1, 1.0f, ng + 3 * DM, ng + 4 * DM);
    } else if (st == nst - 5) {
        const bf16_t* wo = even ? (const bf16_t*)(P.ws + OFF_WT_OUT_EVEN) : (const bf16_t*)(P.ws + OFF_WT_OUT_ODD);
        GemmArgs g{HN, DM, 0, wo + (size_t)li * 1024 * 1024, 1024, 128, 4, 32, 2};
        gemm_phase<EPI_PLAIN>(P, 0, g, OUT, DM);
    } else if (even) {
        if (st == 3) {
            GemmArgs g{HN, DM, 0, (const bf16_t*)(P.ws + OFF_WT_IN_EVEN) + (size_t)li * 2816 * 1024, 1024, 129, 11, 0, 0};
            gemm_phase<EPI_EVEN_IN>(P, li, g, nullptr, 0);
        } else if (st == 4) {
            phase_conv(P, li);
        } else if (st == 5) {
            GemmArgs g{(const bf16_t*)(P.ws + R_UC), 512, 128, (const bf16_t*)(P.ws + OFF_WT_GATES) + (size_t)li * 4 * 256 * 128, 128, 129, 4, 0, 0};
            gemm_phase<EPI_GATES>(P, li, g, nullptr, 0);
        } else if (st == 6) {
            phase_scan3(P, li);
            phase_fox_attn(P, ctrl + 16 * l);
        }
    } else {
        if (st == 3) {
            GemmArgs g{HN, DM, 0, (const bf16_t*)(P.ws + OFF_WT_IN_ODD) + (size_t)li * 3072 * 1024, 1024, 128, 12, 48, 0};
            gemm_phase<EPI_ODD_IN>(P, li, g, nullptr, 0);
        } else if (st == 4) {
            phase_diff_attn(P, li, l, ctrl + 16 * l);
        }
    }
}

#if MULTI_LAUNCH
__global__ void __launch_bounds__(512, 2) phase_kernel(Params P, int ph) { run_phase(P, ph); }
#else
__global__ void __launch_bounds__(512, 2) mega_kernel(Params P) {
    cg::grid_group grid = cg::this_grid();
    if (threadIdx.x < 4) xb_words[threadIdx.x] = 0u;
    __syncthreads();
    const XcdBarrier xb = xcd_barrier_post((unsigned*)(P.ws + OFF_BAR));
    for (int ph = 0; ph < NPHASE; ++ph) {
        run_phase(P, ph);
        if (ph == 0) grid.sync();
        else if (ph + 1 < NPHASE) xcd_barrier(xb);
    }
}
#endif

extern "C" void kernel_launch(void* const* d_in, const int* in_sizes, int n_in, void* d_out, int out_size, void* d_ws, size_t ws_size,
                              hipStream_t stream) {
    Params p{};
    for (int i = 0; i < 24; ++i) p.in[i] = (const float*)d_in[i];
    p.out = (float*)d_out; p.ws = (char*)d_ws;
    if (ws_size < WS_NEEDED) fprintf(stderr, "workspace too small: %zu < %zu\n", ws_size, (size_t)WS_NEEDED);
    hipMemsetAsync(d_ws, 0, 20480, stream);
    static int grid_blocks = 0;
    if (!grid_blocks) {
        int dev = 0, cus = 0, per_cu = 0;
        hipGetDevice(&dev);
        hipDeviceGetAttribute(&cus, hipDeviceAttributeMultiprocessorCount, dev);
#if MULTI_LAUNCH
        hipOccupancyMaxActiveBlocksPerMultiprocessor(&per_cu, phase_kernel, NT, 0);
#else
        hipOccupancyMaxActiveBlocksPerMultiprocessor(&per_cu, mega_kernel, NT, 0);
#endif
        if (per_cu < 1) per_cu = 1;
        if (per_cu > 1) per_cu = 1;
        grid_blocks = cus * per_cu;
    }
#if MULTI_LAUNCH
    for (int ph = 0; ph < NPHASE; ++ph) phase_kernel<<<grid_blocks, NT, 0, stream>>>(p, ph);
#else
    void* args[] = {&p};
    hipError_t e = hipLaunchCooperativeKernel((void*)mega_kernel, dim3(grid_blocks), dim3(NT), args, 0, stream);
    if (e != hipSuccess) fprintf(stderr, "cooperative launch failed: %s (grid %d)\n", hipGetErrorString(e), grid_blocks);
#endif
}
```

```cpp
#include <hip/hip_runtime.h>
#include <hip/hip_cooperative_groups.h>
#include <cstdio>
#include <cstdint>
namespace cg = cooperative_groups;

#ifndef MULTI_LAUNCH
#define MULTI_LAUNCH 0
#endif

#define DI __device__ __forceinline__
#define LDS __attribute__((address_space(3)))
typedef unsigned short bf16_t;
typedef short bf16x8 __attribute__((ext_vector_type(8)));
typedef short s16x4 __attribute__((ext_vector_type(4)));
typedef float f32x16 __attribute__((ext_vector_type(16)));
typedef float f32x4 __attribute__((ext_vector_type(4)));
typedef float f32x2 __attribute__((ext_vector_type(2)));
typedef unsigned u32x4 __attribute__((ext_vector_type(4)));
typedef unsigned u32x2 __attribute__((ext_vector_type(2)));
typedef __bf16 bf2_t __attribute__((ext_vector_type(2)));
#define MFMA(a, b, c) __builtin_amdgcn_mfma_f32_32x32x16_bf16((a), (b), (c), 0, 0, 0)

constexpr int MP = 32768, MS = 256, MT = 33024;
constexpr int DM = 1024, DFF = 2816;
constexpr float LOG2E = 1.4426950408889634f;
constexpr float EPSN = 1e-6f;
constexpr int NT = 512, NW = 8;
constexpr int KVS = 1088;

constexpr size_t OFF_CTRL = 0;
constexpr size_t OFF_BAR = 4096;
constexpr size_t OFF_ROPE = 20480;
constexpr size_t OFF_WT_FFN_IN = OFF_ROPE + 262144;
constexpr size_t OFF_WT_FFN_OUT = OFF_WT_FFN_IN + 92274688;
constexpr size_t OFF_WT_IN_EVEN = OFF_WT_FFN_OUT + 46137344;
constexpr size_t OFF_WT_OUT_EVEN = OFF_WT_IN_EVEN + 11534336;
constexpr size_t OFF_WT_IN_ODD = OFF_WT_OUT_EVEN + 4194304;
constexpr size_t OFF_WT_OUT_ODD = OFF_WT_IN_ODD + 12582912;
constexpr size_t OFF_WT_GATES = OFF_WT_OUT_ODD + 4194304;
constexpr size_t OFF_SACC = OFF_WT_GATES + 524288;
constexpr size_t OFF_HN = OFF_SACC + 1048576;
constexpr size_t OFF_OUT = OFF_HN + 67633152;
constexpr size_t OFF_KS = OFF_OUT + 67633152;
constexpr size_t OFF_VS = OFF_KS + 35651584;
constexpr size_t OFF_R = OFF_VS + 35651584;
constexpr size_t R_ACT = OFF_R;
constexpr size_t R_U = OFF_R;
constexpr size_t R_G = R_U + 67633152;
constexpr size_t R_QE = R_G + 33816576;
constexpr size_t R_KE = R_QE + 33816576;
constexpr size_t R_VE = R_KE + 33554432;
constexpr size_t R_LOGF = R_VE + 33554432;
constexpr size_t R_CBP = R_LOGF + 1056768;
constexpr size_t R_CBS = R_CBP + 1048576;
constexpr size_t R_UC = R_CBS + 557056;
constexpr size_t R_LA = R_UC + 33816576;
constexpr size_t R_IU = R_LA + 67633152;
constexpr size_t R_SEGA = R_IU + 67633152;
constexpr size_t R_SEGB = R_SEGA + 1081344;
constexpr size_t R_EVEN_END = R_SEGB + 1081344;
constexpr size_t R_QO = OFF_R;
constexpr size_t R_KO = R_QO + 67633152;
constexpr size_t R_VO = R_KO + 67108864;
constexpr size_t R_O1 = R_VO + 67108864;
constexpr size_t R_ODD_END = R_O1 + 135266304;
constexpr size_t WS_NEEDED = (R_EVEN_END > R_ODD_END ? R_EVEN_END : R_ODD_END);

constexpr size_t O_Y = 0;
constexpr size_t O_PFK = O_Y + (size_t)MT * 1024;
constexpr size_t O_PFV = O_PFK + 33554432;
constexpr size_t O_PFL = O_PFV + 33554432;
constexpr size_t O_PLH = O_PFL + 524288;
constexpr size_t O_PLC = O_PLH + 8192;
constexpr size_t O_PDK = O_PLC + 24576;
constexpr size_t O_PDV = O_PDK + 67108864;
constexpr size_t O_SFK = O_PDV + 67108864;
constexpr size_t O_SFV = O_SFK + 262144;
constexpr size_t O_SFL = O_SFV + 262144;
constexpr size_t O_SLH = O_SFL + 4096;
constexpr size_t O_SLC = O_SLH + 16384;
constexpr size_t O_SDK = O_SLC + 49152;
constexpr size_t O_SDV = O_SDK + 524288;

enum { I_XP = 0, I_XS, I_CFK, I_CFV, I_CFL, I_SLH, I_SLC, I_CDK, I_CDV, I_NG, I_WFI, I_WFO, I_WIE, I_BFF, I_CW, I_CB, I_WG, I_BG,
       I_LAM, I_WOE, I_WIO, I_DLAM, I_SUBG, I_WOO };

struct Params {
    const float* in[24];
    float* out;
    char* ws;
};

__shared__ __attribute__((aligned(16))) char smem[131072];

DI int tid_opaque() { int t = threadIdx.x; asm volatile("" : "+v"(t)); return t; }
#define TIDX tid_opaque()
DI float bf2f(bf16_t x) { return __uint_as_float(((unsigned)x) << 16); }
DI unsigned pk2(float lo, float hi) { f32x2 v = {lo, hi}; bf2_t b = __builtin_convertvector(v, bf2_t); return __builtin_bit_cast(unsigned, b); }
DI bf16_t f2bf(float x) { return (bf16_t)(pk2(x, 0.f) & 0xffffu); }
DI float wave_sum(float v) {
#pragma unroll
    for (int o = 32; o >= 1; o >>= 1) v += __shfl_xor(v, o);
    return v;
}
DI float sigmoidf_(float x) { return 1.0f / (1.0f + __expf(-x)); }
DI float softplusf_(float x) { return fmaxf(x, 0.f) + log1pf(__expf(-fabsf(x))); }
DI float gelu_tanh(float x) { const float u = 0.7978845608028654f * (x + 0.044715f * x * x * x); return x / (1.0f + __expf(-2.0f * u)); }
DI int crow(int i, int hh) { return (i & 3) + 8 * (i >> 2) + 4 * hh; }

struct WtJob { const float* src; bf16_t* dst; int K, Ns, mode, p0, k0; };
DI WtJob wt_decode(const Params& P, int t) {
    int tt = t, g;
    if (tt < 11264) g = 0; else if ((tt -= 11264) < 5632) g = 1; else if ((tt -= 5632) < 1408) g = 2; else if ((tt -= 1408) < 512) g = 3;
    else if ((tt -= 512) < 1536) g = 4; else { tt -= 1536; g = 5; }
    const float* src; bf16_t* dst; int K = 1024, Ns = 1024, Nd = 1024, mode = 0;
    switch (g) {
        case 0: src = P.in[I_WFI]; dst = (bf16_t*)(P.ws + OFF_WT_FFN_IN); mode = 1; Ns = 5632; Nd = 5632; break;
        case 1: src = P.in[I_WFO]; dst = (bf16_t*)(P.ws + OFF_WT_FFN_OUT); K = 2816; break;
        case 2: src = P.in[I_WIE]; dst = (bf16_t*)(P.ws + OFF_WT_IN_EVEN); Ns = 2568; Nd = 2816; break;
        case 3: src = P.in[I_WOE]; dst = (bf16_t*)(P.ws + OFF_WT_OUT_EVEN); break;
        case 4: src = P.in[I_WIO]; dst = (bf16_t*)(P.ws + OFF_WT_IN_ODD); Ns = 3072; Nd = 3072; break;
        default: src = P.in[I_WOO]; dst = (bf16_t*)(P.ws + OFF_WT_OUT_ODD); break;
    }
    const int npt = Nd / 64, tpm = npt * (K / 64);
    const int mat = tt / tpm, ti = tt % tpm;
    WtJob j; j.src = src + (size_t)mat * K * Ns; j.dst = dst + (size_t)mat * Nd * K; j.K = K; j.Ns = Ns; j.mode = mode; j.p0 = (ti % npt) * 64; j.k0 = (ti / npt) * 64;
    return j;
}
DI void wt_load(const WtJob& j, float (&v)[8]) {
    const int tid = TIDX;
#pragma unroll
    for (int q = 0; q < 8; ++q) {
        const int idx = tid + NT * q, kk = idx >> 6, pp = idx & 63, p = j.p0 + pp;
        int col = p;
        if (j.mode == 1) { const int pn = p >> 8, w = p & 255; col = ((w >> 5) & 1) * DFF + pn * 128 + (w >> 6) * 32 + (w & 31); }
        v[q] = (col < j.Ns) ? j.src[(size_t)(j.k0 + kk) * j.Ns + col] : 0.f;
    }
}
DI void wt_store(const WtJob& j, const float (&v)[8]) {
    float* T = (float*)smem;
    const int tid = TIDX;
#pragma unroll
    for (int q = 0; q < 8; ++q) { const int idx = tid + NT * q; T[(idx >> 6) * 65 + (idx & 63)] = v[q]; }
    __syncthreads();
    {
        const int pp = tid >> 3, ks = (tid & 7) * 8;
        unsigned w[4];
#pragma unroll
        for (int q = 0; q < 4; ++q) w[q] = pk2(T[(ks + 2 * q) * 65 + pp], T[(ks + 2 * q + 1) * 65 + pp]);
        *(u32x4*)(j.dst + (size_t)(j.p0 + pp) * j.K + j.k0 + ks) = (u32x4){w[0], w[1], w[2], w[3]};
    }
    __syncthreads();
}

DI void phase_prologue(const Params& P) {
    const int total = 20864;
    {
        int t = blockIdx.x;
        WtJob job{}; float cur[8];
        if (t < total) { job = wt_decode(P, t); wt_load(job, cur); }
        for (; t < total; t += gridDim.x) {
            const int tn = t + gridDim.x;
            WtJob jobn = job; float nxt[8];
            if (tn < total) { jobn = wt_decode(P, tn); wt_load(jobn, nxt); }
            else {
#pragma unroll
                for (int q = 0; q < 8; ++q) nxt[q] = 0.f;
            }
            wt_store(job, cur);
            job = jobn;
#pragma unroll
            for (int q = 0; q < 8; ++q) cur[q] = nxt[q];
        }
    }
    {
        bf16_t* wgx = (bf16_t*)(P.ws + OFF_WT_GATES);
        const float* wg = P.in[I_WG];
        for (int idx = blockIdx.x * NT + TIDX; idx < 2 * 4 * 256 * 128; idx += gridDim.x * NT) {
            const int k = idx & 127, n = (idx >> 7) & 255, pr = (idx >> 15) & 3, e = idx >> 17;
            float v = 0.f;
            if (n < 128) { if (k < 64) v = wg[((size_t)(e * 8 + 2 * pr) * 64 + k) * 128 + n]; }
            else { if (k >= 64) v = wg[((size_t)(e * 8 + 2 * pr + 1) * 64 + (k - 64)) * 128 + (n - 128)]; }
            wgx[idx] = f2bf(v);
        }
        float* sacc = (float*)(P.ws + OFF_SACC);
        for (int idx = blockIdx.x * NT + TIDX; idx < 256 * 1024; idx += gridDim.x * NT) sacc[idx] = 0.f;
    }
    {
        float* rc = (float*)(P.ws + OFF_ROPE); float* rs = rc + 32768;
        for (int idx = blockIdx.x * NT + TIDX; idx < 32768; idx += gridDim.x * NT) {
            const int pos = idx >> 3, i = idx & 7;
            const float inv = powf(500000.0f, -0.125f * (float)i);
            const float ang = (float)pos * inv;
            const double x = (double)ang;
            const double k = rint(x * 0.15915494309189535);
            const float rr = (float)(x - k * 6.283185307179586);
            rc[idx] = __cosf(rr); rs[idx] = __sinf(rr);
        }
    }
}

DI void phase_norm(const Params& P, int mode, float scale, const float* __restrict__ g_post, const float* __restrict__ g_next) {
    const int lane = TIDX & 63, wave = TIDX >> 6;
    float* X = P.out + O_Y;
    bf16_t* HN = (bf16_t*)(P.ws + OFF_HN);
    const bf16_t* OUT = (const bf16_t*)(P.ws + OFF_OUT);
    for (int row = blockIdx.x * NW + wave; row < MT; row += gridDim.x * NW) {
        f32x4 xv[4];
        if (mode == 0) {
            const float* src = row < MP ? P.in[I_XP] + (size_t)row * DM : P.in[I_XS] + (size_t)(row - MP) * DM;
#pragma unroll
            for (int i = 0; i < 4; ++i) xv[i] = *(const f32x4*)(src + lane * 4 + 256 * i);
        } else {
            f32x4 ov[4], xo[4]; float ss = 0.f;
#pragma unroll
            for (int i = 0; i < 4; ++i) xo[i] = *(const f32x4*)(X + (size_t)row * DM + lane * 4 + 256 * i);
#pragma unroll
            for (int i = 0; i < 4; ++i) {
                if (row < MP) {
                    const u32x2 w = *(const u32x2*)(OUT + (size_t)row * DM + lane * 4 + 256 * i);
                    ov[i] = (f32x4){__uint_as_float(w.x << 16), __uint_as_float(w.x & 0xffff0000u), __uint_as_float(w.y << 16), __uint_as_float(w.y & 0xffff0000u)};
                } else {
                    float* sp = (float*)(P.ws + OFF_SACC) + (size_t)(row - MP) * DM + lane * 4 + 256 * i;
                    ov[i] = *(const f32x4*)sp;
                    *(f32x4*)sp = (f32x4){0.f, 0.f, 0.f, 0.f};
                }
                ss += ov[i].x * ov[i].x + ov[i].y * ov[i].y + ov[i].z * ov[i].z + ov[i].w * ov[i].w;
            }
            ss = wave_sum(ss);
            const float rstd = rsqrtf(ss * (1.0f / 1024.0f) + EPSN) * scale;
#pragma unroll
            for (int i = 0; i < 4; ++i) {
                const f32x4 gp = *(const f32x4*)(g_post + lane * 4 + 256 * i);
                xv[i] = xo[i] + ov[i] * rstd * gp;
            }
        }
#pragma unroll
        for (int i = 0; i < 4; ++i) *(f32x4*)(X + (size_t)row * DM + lane * 4 + 256 * i) = xv[i];
        if (g_next) {
            float ss = 0.f;
#pragma unroll
            for (int i = 0; i < 4; ++i) ss += xv[i].x * xv[i].x + xv[i].y * xv[i].y + xv[i].z * xv[i].z + xv[i].w * xv[i].w;
            ss = wave_sum(ss);
            const float rstd = rsqrtf(ss * (1.0f / 1024.0f) + EPSN);
#pragma unroll
            for (int i = 0; i < 4; ++i) {
                const f32x4 gn = *(const f32x4*)(g_next + lane * 4 + 256 * i);
                const f32x4 hv = xv[i] * rstd * gn;
                *(u32x2*)(HN + (size_t)row * DM + lane * 4 + 256 * i) = (u32x2){pk2(hv.x, hv.y), pk2(hv.z, hv.w)};
            }
        }
    }
}

DI void cache_prep(const float* __restrict__ ck, const float* __restrict__ cv, bf16_t* __restrict__ KS, bf16_t* __restrict__ VS_, int W) {
    const int cpr = W / 8;
    const int nch = 16 * 1024 * cpr;
    const int gsz = gridDim.x * NT;
    for (int idx0 = blockIdx.x * NT + TIDX; idx0 < 2 * nch; idx0 += 4 * gsz) {
        f32x4 a[4], bb[4]; bf16_t* d[4]; bool ok[4];
#pragma unroll
        for (int u = 0; u < 4; ++u) {
            const int idx = idx0 + u * gsz; ok[u] = idx < 2 * nch;
            const int idc = ok[u] ? idx : idx0;
            const int which = idc >= nch; const int id = which ? idc - nch : idc;
            const int c = id % cpr, rowg = id / cpr, b = rowg >> 10, k = rowg & 1023;
            const float* sp = (which ? cv : ck) + (size_t)rowg * W + c * 8;
            a[u] = *(const f32x4*)sp; bb[u] = *(const f32x4*)(sp + 4);
            d[u] = (which ? VS_ : KS) + ((size_t)(b * KVS + k)) * W + c * 8;
        }
#pragma unroll
        for (int u = 0; u < 4; ++u)
            if (ok[u]) *(u32x4*)d[u] = (u32x4){pk2(a[u].x, a[u].y), pk2(a[u].z, a[u].w), pk2(bb[u].x, bb[u].y), pk2(bb[u].z, bb[u].w)};
    }
    const int nz = 16 * 48 * cpr;
    for (int idx = blockIdx.x * NT + TIDX; idx < 2 * nz; idx += gridDim.x * NT) {
        const int which = idx >= nz; const int id = which ? idx - nz : idx;
        const int c = id % cpr, rowg = id / cpr, b = rowg / 48, k = 1040 + rowg % 48;
        bf16_t* d = (which ? VS_ : KS) + ((size_t)(b * KVS + k)) * W + c * 8;
        *(u32x4*)d = (u32x4){0u, 0u, 0u, 0u};
    }
}

struct GemmArgs { const bf16_t* A; int lda; int a_pn_stride; const bf16_t* Bt; int K; int nM, nN; int nsk, skc; };
enum { EPI_PLAIN = 0, EPI_SWIGLU, EPI_EVEN_IN, EPI_GATES, EPI_ODD_IN, EPI_SACC };

DI bool gemm_next(int it, int nM, int nN, int& pm, int& pn) {
    const int G = gridDim.x;
    if ((G & 7) == 0) {
        const int x = blockIdx.x & 7, bl = blockIdx.x >> 3, bpx = G >> 3, j = bl + it * bpx;
        const int nMx = (nM - x + 7) >> 3;
        if (j >= nMx * nN) return false;
        const int grp = j / (8 * nN), within = j % (8 * nN);
        int gsz = nMx - grp * 8; if (gsz > 8) gsz = 8;
        pn = within / gsz; pm = x + 8 * (grp * 8 + within % gsz);
        return true;
    } else {
        const int t = blockIdx.x + it * G;
        if (t >= nM * nN) return false;
        pm = t / nN; pn = t % nN; return true;
    }
}

template <int EPI, bool QUARTER = false>
DI void gemm_epilogue(const Params& P, int li, const f32x16 (&acc)[4][2], int pm, int pn, bf16_t* __restrict__ C, int ldc, int q = 0) {
    const int tid = TIDX, lane = tid & 63, wave = tid >> 6, wr = wave >> 2, wc = QUARTER ? q : (wave & 3), r = lane & 31, hh = lane >> 5;
    const int m0 = QUARTER ? pm * 256 + wave * 32 : pm * 256 + wr * 128;
    constexpr int NMT = QUARTER ? 1 : 4;
    const bool samp = pm * 256 >= MP;
    if (EPI == EPI_PLAIN) {
#pragma unroll
        for (int mt = 0; mt < 4; ++mt)
#pragma unroll
            for (int i = 0; i < 16; ++i) {
                const int row = m0 + mt * 32 + crow(i, hh);
#pragma unroll
                for (int nt = 0; nt < 2; ++nt) C[(size_t)row * ldc + pn * 256 + wc * 64 + nt * 32 + r] = f2bf(acc[mt][nt][i]);
            }
    } else if (EPI == EPI_SACC) {
        float* S = (float*)(P.ws + OFF_SACC);
#pragma unroll
        for (int mt = 0; mt < 4; ++mt)
#pragma unroll
            for (int i = 0; i < 16; ++i) {
                const int row = wr * 128 + mt * 32 + crow(i, hh);
#pragma unroll
                for (int nt = 0; nt < 2; ++nt) atomicAdd(S + (size_t)row * DM + pn * 256 + wc * 64 + nt * 32 + r, acc[mt][nt][i]);
            }
    } else if (EPI == EPI_SWIGLU) {
        const int j = pn * 128 + wc * 32 + r;
#pragma unroll
        for (int mt = 0; mt < 4; ++mt)
#pragma unroll
            for (int i = 0; i < 16; ++i) {
                const int row = m0 + mt * 32 + crow(i, hh);
                const float g = acc[mt][0][i], u = acc[mt][1][i];
                C[(size_t)row * DFF + j] = f2bf(g / (1.0f + __expf(-g)) * u);
            }
    } else if (EPI == EPI_EVEN_IN) {
        const int e = li;
        const int sec = (pn * 256) >> 9;
        const int cb0 = ((pn * 256) & 511) + wc * 64 + r;
        if (sec == 0) {
            float* U = (float*)(P.ws + R_U);
#pragma unroll
            for (int mt = 0; mt < 4; ++mt)
#pragma unroll
                for (int i = 0; i < 16; ++i) {
                    const int row = m0 + mt * 32 + crow(i, hh);
#pragma unroll
                    for (int nt = 0; nt < 2; ++nt) U[(size_t)row * 512 + cb0 + nt * 32] = acc[mt][nt][i];
                }
        } else if (sec == 1) {
            bf16_t* Gb = (bf16_t*)(P.ws + R_G);
#pragma unroll
            for (int mt = 0; mt < 4; ++mt)
#pragma unroll
                for (int i = 0; i < 16; ++i) {
                    const int row = m0 + mt * 32 + crow(i, hh);
#pragma unroll
                    for (int nt = 0; nt < 2; ++nt) Gb[(size_t)row * 512 + cb0 + nt * 32] = f2bf(gelu_tanh(acc[mt][nt][i]));
                }
        } else if (sec == 2) {
            bf16_t* QE = (bf16_t*)(P.ws + R_QE);
#pragma unroll
            for (int mt = 0; mt < 4; ++mt)
#pragma unroll
                for (int i = 0; i < 16; ++i) {
                    const int row = m0 + mt * 32 + crow(i, hh);
#pragma unroll
                    for (int nt = 0; nt < 2; ++nt) QE[(size_t)row * 512 + cb0 + nt * 32] = f2bf(acc[mt][nt][i] * (0.125f * LOG2E));
                }
        } else if (sec == 3 || sec == 4) {
            bf16_t* bb; float* ob;
            if (!samp) { bb = (bf16_t*)(P.ws + (sec == 3 ? R_KE : R_VE)); ob = P.out + (sec == 3 ? O_PFK : O_PFV) + (size_t)e * (8 * 4096 * 512); }
            else { bb = (bf16_t*)(P.ws + (sec == 3 ? OFF_KS : OFF_VS)); ob = P.out + (sec == 3 ? O_SFK : O_SFV) + (size_t)e * (16 * 16 * 512); }
#pragma unroll
            for (int mt = 0; mt < 4; ++mt)
#pragma unroll
                for (int i = 0; i < 16; ++i) {
                    const int row = m0 + mt * 32 + crow(i, hh);
                    const int mm = row - MP;
                    const size_t rb = samp ? (size_t)((mm >> 4) * KVS + 1024 + (mm & 15)) : (size_t)row;
                    const size_t ro = samp ? (size_t)mm : (size_t)row;
#pragma unroll
                    for (int nt = 0; nt < 2; ++nt) {
                        const float v = acc[mt][nt][i];
                        bb[rb * 512 + cb0 + nt * 32] = f2bf(v);
                        __builtin_nontemporal_store(v, ob + ro * 512 + cb0 + nt * 32);
                    }
                }
        } else {
            float* LF = (float*)(P.ws + R_LOGF);
            if (cb0 < 8) {
                const float bf_ = P.in[I_BFF][e * 8 + cb0];
#pragma unroll
                for (int mt = 0; mt < 4; ++mt)
#pragma unroll
                    for (int i = 0; i < 16; ++i) {
                        const int row = m0 + mt * 32 + crow(i, hh);
                        const int mm = row - MP;
                        const float lf = -softplusf_(-(acc[mt][0][i] + bf_));
                        LF[(size_t)row * 8 + cb0] = lf;
                        if (!samp) P.out[O_PFL + (size_t)e * (8 * 4096 * 8) + (size_t)row * 8 + cb0] = lf;
                        else P.out[O_SFL + (size_t)e * (16 * 16 * 8) + (size_t)mm * 8 + cb0] = lf;
                    }
            }
        }
    } else if (EPI == EPI_GATES) {
        const int e = li, blk = 2 * pn + (wc >> 1);
        float* LA = (float*)(P.ws + R_LA); float* IU = (float*)(P.ws + R_IU); const bf16_t* UC = (const bf16_t*)(P.ws + R_UC);
#pragma unroll
        for (int nt = 0; nt < 2; ++nt) {
            const int n = (wc & 1) * 64 + nt * 32 + r, ch = blk * 64 + (n & 63);
            const float bias = P.in[I_BG][(e * 8 + blk) * 128 + n];
            const float sp = softplusf_(-P.in[I_LAM][e * 512 + ch]);
#pragma unroll
            for (int mt = 0; mt < 4; ++mt)
#pragma unroll
                for (int i = 0; i < 16; ++i) {
                    const int row = m0 + mt * 32 + crow(i, hh);
                    const float sg = sigmoidf_(acc[mt][nt][i] + bias);
                    if ((wc & 1) == 0) LA[(size_t)row * 512 + ch] = -8.0f * sg * sp;
                    else IU[(size_t)row * 512 + ch] = sg * bf2f(UC[(size_t)row * 512 + ch]);
                }
        }
    } else if (EPI == EPI_ODD_IN) {
        const int o = li;
        const int sec = (pn * 256) >> 10;
        bf16_t* QO = (bf16_t*)(P.ws + R_QO); bf16_t* KO = (bf16_t*)(P.ws + R_KO); bf16_t* VO = (bf16_t*)(P.ws + R_VO);
        bf16_t* KSb = (bf16_t*)(P.ws + OFF_KS); bf16_t* VSb = (bf16_t*)(P.ws + OFF_VS);
        const float* rc = (const float*)(P.ws + OFF_ROPE); const float* rs = rc + 32768;
#pragma unroll
        for (int mt = 0; mt < NMT; ++mt)
#pragma unroll
            for (int i = 0; i < 16; ++i) {
                const int row = m0 + mt * 32 + crow(i, hh);
                const int mm = row - MP;
                const int pos = samp ? 1024 + (mm & 15) : (row & 4095);
#pragma unroll
                for (int nt = 0; nt < 2; ++nt) {
                    const int c = ((pn * 256) & 1023) + wc * 64 + nt * 32 + r;
                    float v = acc[mt][nt][i];
                    if (sec < 2 && nt == 0) {
                        const float other = __shfl_xor(v, 8);
                        const float cs = rc[pos * 8 + (r & 7)], sn = rs[pos * 8 + (r & 7)];
                        if (r < 8) v = v * cs - other * sn;
                        else if (r < 16) v = v * cs + other * sn;
                    }
                    if (sec == 0) QO[(size_t)row * 1024 + c] = f2bf(v * (0.125f * LOG2E));
                    else {
                        bf16_t* dstb; float* dsto;
                        if (!samp) {
                            dstb = (sec == 1 ? KO : VO) + (size_t)row * 1024 + c;
                            dsto = P.out + (sec == 1 ? O_PDK : O_PDV) + (size_t)o * (8 * 4096 * 1024) + (size_t)row * 1024 + c;
                        } else {
                            dstb = (sec == 1 ? KSb : VSb) + ((size_t)((mm >> 4) * KVS + 1024 + (mm & 15))) * 1024 + c;
                            dsto = P.out + (sec == 1 ? O_SDK : O_SDV) + (size_t)o * (16 * 16 * 1024) + (size_t)mm * 1024 + c;
                        }
                        *dstb = f2bf(v); __builtin_nontemporal_store(v, dsto);
                    }
                }
            }
    }
}

template <bool QUARTER>
DI void gemm_tile_loop(const bf16_t* __restrict__ Ap, int lda, const bf16_t* __restrict__ Bp, int ldb, int ks0, int nks, f32x16 (&acc)[4][2], int q = 0) {
    const int tid = TIDX, lane = tid & 63, wave = tid >> 6, wr = wave >> 2, wc = wave & 3, r = lane & 31, hh = lane >> 5;
    const int sc = tid & 7, sr = tid >> 3;
    LDS char* sm = (LDS char*)smem;
#pragma unroll
    for (int a = 0; a < 4; ++a)
#pragma unroll
        for (int b = 0; b < 2; ++b)
#pragma unroll
            for (int i = 0; i < 16; ++i) acc[a][b][i] = 0.f;
    const unsigned aoff = (unsigned)(sr * lda + sc * 8) * 2u, astep = (unsigned)(64 * lda) * 2u;
    const unsigned boff = (unsigned)(sr * ldb + sc * 8) * 2u, bstep = (unsigned)(64 * ldb) * 2u;
    const int soff = sr * 128 + ((sc ^ ((sr >> 1) & 7)) << 4);
    const char* ap = (const char*)Ap + (size_t)ks0 * 128;
    const char* bp = (const char*)Bp + (size_t)ks0 * 128;
    u32x4 r0a[4], r0b[4], r1a[4], r1b[4];
    auto gload = [&](u32x4 (&ra)[4], u32x4 (&rb)[4], int st) {
        const char* a = ap + (size_t)st * 128; const char* b = bp + (size_t)st * 128;
#pragma unroll
        for (int i = 0; i < 4; ++i) { ra[i] = *(const u32x4*)(a + aoff + i * astep); rb[i] = *(const u32x4*)(b + boff + i * bstep); }
    };
    auto swrite = [&](const u32x4 (&ra)[4], const u32x4 (&rb)[4], int buf) {
#pragma unroll
        for (int i = 0; i < 4; ++i) { *(LDS u32x4*)(sm + buf * 65536 + soff + i * 8192) = ra[i]; *(LDS u32x4*)(sm + buf * 65536 + 32768 + soff + i * 8192) = rb[i]; }
    };
    const int arow = QUARTER ? (wave * 32 + r) * 128 : (wr * 128 + r) * 128, brow = 32768 + ((QUARTER ? q : wc) * 64 + r) * 128, swz = (r >> 1) & 7;
    auto compute = [&](int buf) {
#pragma unroll
        for (int ks = 0; ks < 4; ++ks) {
            const int ch = (((ks << 1) | hh) ^ swz) << 4;
            bf16x8 af[4], bfr[2];
#pragma unroll
            for (int t = 0; t < (QUARTER ? 1 : 4); ++t) af[t] = *(LDS bf16x8*)(sm + buf * 65536 + arow + t * 4096 + ch);
#pragma unroll
            for (int t = 0; t < 2; ++t) bfr[t] = *(LDS bf16x8*)(sm + buf * 65536 + brow + t * 4096 + ch);
#pragma unroll
            for (int mt = 0; mt < (QUARTER ? 1 : 4); ++mt)
#pragma unroll
                for (int nt = 0; nt < 2; ++nt) acc[mt][nt] = MFMA(af[mt], bfr[nt], acc[mt][nt]);
        }
    };
    gload(r0a, r0b, 0);
    if (nks > 1) gload(r1a, r1b, 1);
    swrite(r0a, r0b, 0);
    __syncthreads();
    if (nks > 2) gload(r0a, r0b, 2);
    for (int kt = 0; kt < nks; kt += 2) {
        compute(0);
        if (kt + 1 < nks) swrite(r1a, r1b, 1);
        __syncthreads();
        if (kt + 3 < nks) gload(r1a, r1b, kt + 3);
        if (kt + 1 < nks) {
            compute(1);
            if (kt + 2 < nks) swrite(r0a, r0b, 0);
            __syncthreads();
            if (kt + 4 < nks) gload(r0a, r0b, kt + 4);
        }
    }
}

template <int EPI>
DI void gemm_phase(const Params& P, int li, const GemmArgs g, bf16_t* __restrict__ C, int ldc) {
    int pm, pn, it = 0;
    for (; gemm_next(it, g.nM, g.nN, pm, pn); ++it) {
        const bf16_t* Ap = g.A + (size_t)(pm * 256) * g.lda + (size_t)pn * g.a_pn_stride;
        const bf16_t* Bp = g.Bt + (size_t)(pn * 256) * g.K;
        f32x16 acc[4][2];
        gemm_tile_loop<false>(Ap, g.lda, Bp, g.K, 0, g.K >> 6, acc);
        gemm_epilogue<EPI>(P, li, acc, pm, pn, C, ldc);
        if (EPI == EPI_GATES) {
            __syncthreads();
            const float* LA = (const float*)(P.ws + R_LA); const float* IU = (const float*)(P.ws + R_IU);
            float* SA = (float*)(P.ws + R_SEGA); float* SB = (float*)(P.ws + R_SEGB);
            const bool smp = pm == 128;
            const int nit = (smp ? 16 : 4) * 128, len = smp ? 16 : 64;
            for (int item = TIDX; item < nit; item += NT) {
                const int sl = item >> 7, ch = pn * 128 + (item & 127);
                const int seg = smp ? 512 + sl : pm * 4 + sl, row0 = smp ? MP + sl * 16 : pm * 256 + sl * 64;
                float h = 0.f, p = 1.f;
                for (int j0 = 0; j0 < len; j0 += 8) {
                    float la[8], iu[8];
#pragma unroll
                    for (int j = 0; j < 8; ++j) { la[j] = LA[(size_t)(row0 + j0 + j) * 512 + ch]; iu[j] = IU[(size_t)(row0 + j0 + j) * 512 + ch]; }
#pragma unroll
                    for (int j = 0; j < 8; ++j) {
                        const float a = __expf(la[j]), bx = sqrtf(-expm1f(2.0f * la[j])) * iu[j];
                        h = a * h + bx; p *= a;
                    }
                }
                SA[seg * 512 + ch] = p; SB[seg * 512 + ch] = h;
            }
        }
    }
    if (EPI == EPI_SWIGLU) {
        const int tid = TIDX, lane = tid & 63, wave = tid >> 6, r = lane & 31, hh = lane >> 5;
        for (int j = (int)gridDim.x - 1 - (int)blockIdx.x; j < g.nsk; j += gridDim.x) {
            const int pn2 = j >> 2, q = j & 3;
            const bf16_t* Ap = g.A + (size_t)MP * g.lda;
            const bf16_t* Bp = g.Bt + (size_t)(pn2 * 256) * g.K;
            f32x16 acc[4][2];
            gemm_tile_loop<true>(Ap, g.lda, Bp, g.K, 0, g.K >> 6, acc, q);
            const int jc = pn2 * 128 + q * 32 + r;
#pragma unroll
            for (int i = 0; i < 16; ++i) {
                const int row = MP + wave * 32 + crow(i, hh);
                const float gv = acc[0][0][i], uv = acc[0][1][i];
                C[(size_t)row * DFF + jc] = f2bf(gv / (1.0f + __expf(-gv)) * uv);
            }
        }
    }
    if (EPI == EPI_ODD_IN) {
        for (int j = (int)gridDim.x - 1 - (int)blockIdx.x; j < g.nsk; j += gridDim.x) {
            const int pn2 = j >> 2, q = j & 3;
            const bf16_t* Ap = g.A + (size_t)MP * g.lda;
            const bf16_t* Bp = g.Bt + (size_t)(pn2 * 256) * g.K;
            f32x16 acc[4][2];
            gemm_tile_loop<true>(Ap, g.lda, Bp, g.K, 0, g.K >> 6, acc, q);
            gemm_epilogue<EPI_ODD_IN, true>(P, li, acc, 128, pn2, nullptr, 0, q);
        }
    }
    if (EPI == EPI_PLAIN) {
        for (int j = (int)gridDim.x - 1 - (int)blockIdx.x; j < g.nsk; j += gridDim.x) {
            const int pn2 = j % g.nN, kc = j / g.nN;
            const bf16_t* Ap = g.A + (size_t)MP * g.lda;
            const bf16_t* Bp = g.Bt + (size_t)(pn2 * 256) * g.K;
            f32x16 acc[4][2];
            gemm_tile_loop<false>(Ap, g.lda, Bp, g.K, kc * g.skc, g.skc, acc);
            gemm_epilogue<EPI_SACC>(P, li, acc, 128, pn2, nullptr, 0);
        }
    }
}

DI void phase_conv(const Params& P, int e) {
    const float* __restrict__ U = (const float*)(P.ws + R_U);
    bf16_t* __restrict__ UC = (bf16_t*)(P.ws + R_UC);
    const float* cw = P.in[I_CW] + e * 4 * 512; const float* cbias = P.in[I_CB] + e * 512;
    const float* sbuf = P.in[I_SLC] + (size_t)e * 16 * 3 * 512;
    const int gtid = blockIdx.x * NT + TIDX, gsz = gridDim.x * NT;
    for (int idx = gtid; idx < MT * 128; idx += gsz) {
        const int row = idx >> 7, c = (idx & 127) * 4;
        int t, b; const bool samp = row >= MP;
        if (!samp) { t = row & 4095; b = row >> 12; } else { t = (row - MP) & 15; b = (row - MP) >> 4; }
        f32x4 acc = *(const f32x4*)(cbias + c);
#pragma unroll
        for (int j = 0; j < 4; ++j) {
            const int tt = t - 3 + j;
            f32x4 uv;
            if (tt >= 0) uv = *(const f32x4*)(U + (size_t)(row - 3 + j) * 512 + c);
            else if (samp) uv = *(const f32x4*)(sbuf + ((size_t)b * 3 + (3 + tt)) * 512 + c);
            else uv = (f32x4){0.f, 0.f, 0.f, 0.f};
            acc += uv * *(const f32x4*)(cw + j * 512 + c);
        }
        *(u32x2*)(UC + (size_t)row * 512 + c) = (u32x2){pk2(acc.x, acc.y), pk2(acc.z, acc.w)};
    }
    for (int idx = gtid; idx < (8 + 16) * 3 * 512; idx += gsz) {
        const int c = idx & 511, i = (idx >> 9) % 3, s = idx / 1536;
        if (s < 8) P.out[O_PLC + ((size_t)(e * 8 + s) * 3 + i) * 512 + c] = U[(size_t)(s * 4096 + 4093 + i) * 512 + c];
        else P.out[O_SLC + ((size_t)(e * 16 + (s - 8)) * 3 + i) * 512 + c] = U[(size_t)(MP + (s - 8) * 16 + 13 + i) * 512 + c];
    }
    const float* LF = (const float*)(P.ws + R_LOGF);
    float* CBP = (float*)(P.ws + R_CBP); float* CBS = (float*)(P.ws + R_CBS);
    const int lane = TIDX & 63;
    for (int w = blockIdx.x * NW + (TIDX >> 6); w < 64 + 128; w += gridDim.x * NW) {
        if (w < 64) {
            const int s = w >> 3, h = w & 7;
            float loc = 0.f;
            for (int j0 = 0; j0 < 64; j0 += 16) {
                float v[16];
#pragma unroll
                for (int j = 0; j < 16; ++j) v[j] = LF[(size_t)(s * 4096 + lane * 64 + j0 + j) * 8 + h];
#pragma unroll
                for (int j = 0; j < 16; ++j) loc += v[j];
            }
            float inc = loc;
#pragma unroll
            for (int o = 1; o < 64; o <<= 1) { const float t = __shfl_up(inc, o); if (lane >= o) inc += t; }
            float run = inc - loc;
            for (int j0 = 0; j0 < 64; j0 += 16) {
                float v[16];
#pragma unroll
                for (int j = 0; j < 16; ++j) v[j] = LF[(size_t)(s * 4096 + lane * 64 + j0 + j) * 8 + h];
#pragma unroll
                for (int j = 0; j < 16; ++j) { run += v[j]; v[j] = -run * LOG2E; }
#pragma unroll
                for (int j = 0; j < 16; ++j) CBP[(size_t)(s * 8 + h) * 4096 + lane * 64 + j0 + j] = v[j];
            }
        } else {
            const int b = (w - 64) >> 3, h = (w - 64) & 7;
            const float* cl = P.in[I_CFL] + (size_t)(e * 16 + b) * 1024 * 8;
            float loc = 0.f;
            for (int j = 0; j < 17; ++j) {
                const int k = lane * 17 + j;
                float v = 0.f;
                if (k < 1024) v = cl[(size_t)k * 8 + h]; else if (k < 1040) v = LF[(size_t)(MP + b * 16 + (k - 1024)) * 8 + h];
                loc += v;
            }
            float inc = loc;
#pragma unroll
            for (int o = 1; o < 64; o <<= 1) { const float t = __shfl_up(inc, o); if (lane >= o) inc += t; }
            float run = inc - loc;
            for (int j = 0; j < 17; ++j) {
                const int k = lane * 17 + j;
                float v = 0.f;
                if (k < 1024) v = cl[(size_t)k * 8 + h]; else if (k < 1040) v = LF[(size_t)(MP + b * 16 + (k - 1024)) * 8 + h];
                run += v;
                CBS[(size_t)(b * 8 + h) * KVS + k] = -run * LOG2E;
            }
        }
    }
}

DI void seg_info(int seg, int& row0, int& len) { if (seg < 512) { row0 = seg * 64; len = 64; } else { row0 = MP + (seg - 512) * 16; len = 16; } }

DI void phase_scan1(const Params& P) {
    const float* LA = (const float*)(P.ws + R_LA); const float* IU = (const float*)(P.ws + R_IU);
    float* SA = (float*)(P.ws + R_SEGA); float* SB = (float*)(P.ws + R_SEGB);
    for (int idx = blockIdx.x * NT + TIDX; idx < 528 * 512; idx += gridDim.x * NT) {
        const int seg = idx >> 9, c = idx & 511;
        int row0, len; seg_info(seg, row0, len);
        float h = 0.f, p = 1.f;
        for (int j0 = 0; j0 < len; j0 += 8) {
            float la[8], iu[8];
#pragma unroll
            for (int j = 0; j < 8; ++j) { la[j] = LA[(size_t)(row0 + j0 + j) * 512 + c]; iu[j] = IU[(size_t)(row0 + j0 + j) * 512 + c]; }
#pragma unroll
            for (int j = 0; j < 8; ++j) {
                const float a = __expf(la[j]), bx = sqrtf(-expm1f(2.0f * la[j])) * iu[j];
                h = a * h + bx; p *= a;
            }
        }
        SA[idx] = p; SB[idx] = h;
    }
}

DI void phase_scan3(const Params& P, int e) {
    const float* LA = (const float*)(P.ws + R_LA); const float* IU = (const float*)(P.ws + R_IU);
    const float* SA = (const float*)(P.ws + R_SEGA); const float* SB = (const float*)(P.ws + R_SEGB);
    const bf16_t* Gb = (const bf16_t*)(P.ws + R_G);
    bf16_t* MIX = (bf16_t*)(P.ws + OFF_HN);
    for (int idx = blockIdx.x * NT + TIDX; idx < 528 * 512; idx += gridDim.x * NT) {
        const int seg = idx >> 9, c = idx & 511;
        int row0, len; seg_info(seg, row0, len);
        float h = 0.f;
        if (seg < 512) {
            const int s0 = seg & ~63;
            for (int sb = s0; sb < seg; sb += 8) {
                float sa[8], sbv[8];
#pragma unroll
                for (int j = 0; j < 8; ++j) { const int sj = (sb + j < seg) ? sb + j : s0; sa[j] = SA[sj * 512 + c]; sbv[j] = SB[sj * 512 + c]; }
#pragma unroll
                for (int j = 0; j < 8; ++j) if (sb + j < seg) h = sa[j] * h + sbv[j];
            }
        }
        else h = P.in[I_SLH][(size_t)(e * 16 + (seg - 512)) * 512 + c];
        for (int j0 = 0; j0 < len; j0 += 8) {
            float la[8], iu[8], gg[8], y[8];
#pragma unroll
            for (int j = 0; j < 8; ++j) {
                la[j] = LA[(size_t)(row0 + j0 + j) * 512 + c]; iu[j] = IU[(size_t)(row0 + j0 + j) * 512 + c];
                gg[j] = bf2f(Gb[(size_t)(row0 + j0 + j) * 512 + c]);
            }
#pragma unroll
            for (int j = 0; j < 8; ++j) {
                const float a = __expf(la[j]), bx = sqrtf(-expm1f(2.0f * la[j])) * iu[j];
                h = a * h + bx; y[j] = h * gg[j];
            }
#pragma unroll
            for (int j = 0; j < 8; ++j) MIX[(size_t)(row0 + j0 + j) * 1024 + c] = f2bf(y[j]);
        }
        if (seg < 512) { if ((seg & 63) == 63) P.out[O_PLH + (size_t)(e * 8 + (seg >> 6)) * 512 + c] = h; }
        else P.out[O_SLH + (size_t)(e * 16 + (seg - 512)) * 512 + c] = h;
    }
}

template <int DV, bool BIAS>
DI void flash_pass(const bf16_t* __restrict__ Qb, int ldq, const bf16_t* __restrict__ Kb, int ldk, const bf16_t* __restrict__ Vb, int ldv,
                   const float* __restrict__ cb, int q0, int nq, int past, int mode, int kvlen, f32x16 (&O)[DV / 32], float& l_out) {
    constexpr int VSTR = (DV == 64) ? 192 : 320;
    constexpr int BUFSZ = 8192 + 64 * VSTR + 256;
    constexpr int VCH = DV / 8, NVL = (64 * VCH) / NT;
    const int tid = TIDX, lane = tid & 63, wave = tid >> 6, r = lane & 31, hh = lane >> 5;
    LDS char* sm = (LDS char*)smem;
    const int qw0 = q0 + wave * 32;
    const bool wactive = qw0 < nq;
    int qi = qw0 + r; if (qi > nq - 1) qi = nq - 1;
    const int qabs = past + qi;
    int klim = qabs; if (mode == 1) { klim = qabs | 63; if (klim > kvlen - 1) klim = kvlen - 1; }
    int qlw = qw0 + 31; if (qlw > nq - 1) qlw = nq - 1;
    int wkmax = past + qlw; if (mode == 1) { wkmax |= 63; if (wkmax > kvlen - 1) wkmax = kvlen - 1; }
    const int wkmin = (mode == 0) ? past + qw0 : wkmax;
    int qlb = q0 + NW * 32 - 1; if (qlb > nq - 1) qlb = nq - 1;
    int bkmax = past + qlb; if (mode == 1) { bkmax |= 63; if (bkmax > kvlen - 1) bkmax = kvlen - 1; }
    const int ntiles = (bkmax >> 6) + 1;

    bf16x8 qf[4];
#pragma unroll
    for (int ks = 0; ks < 4; ++ks) qf[ks] = *(const bf16x8*)(Qb + (size_t)qi * ldq + ks * 16 + hh * 8);
#pragma unroll
    for (int dt = 0; dt < DV / 32; ++dt)
#pragma unroll
        for (int i = 0; i < 16; ++i) O[dt][i] = 0.f;
    float m = -1e30f, l = 0.f;

    u32x4 rk[1], rv[NVL]; f32x4 rc4 = {0.f, 0.f, 0.f, 0.f};
    unsigned koff[1], vofs[NVL];
#pragma unroll
    for (int i = 0; i < 1; ++i) { const int idx = tid + NT * i, row = idx >> 3, c = idx & 7; koff[i] = (unsigned)(row * ldk + c * 8) * 2u; }
#pragma unroll
    for (int i = 0; i < NVL; ++i) { const int idx = tid + NT * i, row = idx / VCH, c = idx % VCH; vofs[i] = (unsigned)(row * ldv + c * 8) * 2u; }
    auto prefetch = [&](int kt) {
        const char* kp = (const char*)Kb + (size_t)kt * 128 * ldk;
        const char* vp = (const char*)Vb + (size_t)kt * 128 * ldv;
#pragma unroll
        for (int i = 0; i < 1; ++i) rk[i] = *(const u32x4*)(kp + koff[i]);
        if (DV == 64) {
#pragma unroll
            for (int i = 0; i < NVL; ++i) rv[i] = *(const u32x4*)(vp + vofs[i]);
        }
        if (BIAS) { if (tid < 16) rc4 = *(const f32x4*)(cb + kt * 64 + tid * 4); }
    };
    auto late_v = [&](int kt) {
        if (DV != 64) {
            const char* vp = (const char*)Vb + (size_t)kt * 128 * ldv;
#pragma unroll
            for (int i = 0; i < NVL; ++i) rv[i] = *(const u32x4*)(vp + vofs[i]);
        }
    };
    auto stash = [&](int buf) {
        LDS char* b = sm + buf * BUFSZ;
#pragma unroll
        for (int i = 0; i < 1; ++i) { const int idx = tid + NT * i, row = idx >> 3, c = idx & 7; *(LDS u32x4*)(b + row * 128 + ((c ^ ((row >> 1) & 7)) << 4)) = rk[i]; }
#pragma unroll
        for (int i = 0; i < NVL; ++i) { const int idx = tid + NT * i, row = idx / VCH, c = idx % VCH; *(LDS u32x4*)(b + 8192 + row * VSTR + c * 16) = rv[i]; }
        if (BIAS) { if (tid < 16) *(LDS f32x4*)(b + 8192 + 64 * VSTR + tid * 16) = rc4; }
    };
    prefetch(0); late_v(0); stash(0); __syncthreads();
    const int q4 = (lane & 15) >> 2, p4 = lane & 3, g1 = (lane >> 4) & 1;
    const int voff = (4 * hh + q4) * VSTR + (16 * g1 + 4 * p4) * 2;
    for (int kt = 0; kt < ntiles; ++kt) {
        if (kt + 1 < ntiles) prefetch(kt + 1);
        if (wactive && kt * 64 <= wkmax) {
            LDS char* kb = sm + (kt & 1) * BUFSZ; LDS char* vb = kb + 8192; LDS char* cbp = vb + 64 * VSTR;
            const bool need_mask = kt * 64 + 63 > wkmin;
#pragma unroll
            for (int st = 0; st < 2; ++st) {
                asm volatile("" ::: "memory");
                f32x16 S;
#pragma unroll
                for (int i = 0; i < 16; ++i) S[i] = 0.f;
#pragma unroll
                for (int ks = 0; ks < 4; ++ks) {
                    const bf16x8 a = *(LDS bf16x8*)(kb + (st * 32 + r) * 128 + ((((ks << 1) | hh) ^ ((r >> 1) & 7)) << 4));
                    S = MFMA(a, qf[ks], S);
                }
                if (BIAS) {
#pragma unroll
                    for (int g = 0; g < 4; ++g) {
                        const f32x4 c4 = *(LDS f32x4*)(cbp + (st * 32 + 8 * g + 4 * hh) * 4);
                        S[4 * g + 0] += c4.x; S[4 * g + 1] += c4.y; S[4 * g + 2] += c4.z; S[4 * g + 3] += c4.w;
                    }
                }
                if (need_mask) {
#pragma unroll
                    for (int i = 0; i < 16; ++i) { const int key = kt * 64 + st * 32 + crow(i, hh); if (key > klim) S[i] = -1e30f; }
                }
                float mx = S[0];
#pragma unroll
                for (int i = 1; i < 16; ++i) mx = fmaxf(mx, S[i]);
                mx = fmaxf(mx, __shfl_xor(mx, 32));
                if (__any(mx > m)) {
                    const float mn = fmaxf(m, mx);
                    const float alpha = __builtin_amdgcn_exp2f(m - mn);
                    m = mn; l *= alpha;
#pragma unroll
                    for (int dt = 0; dt < DV / 32; ++dt)
#pragma unroll
                        for (int i = 0; i < 16; ++i) O[dt][i] *= alpha;
                }
                float ps = 0.f;
#pragma unroll
                for (int i = 0; i < 16; ++i) { const float p = __builtin_amdgcn_exp2f(S[i] - m); S[i] = p; ps += p; }
                l += ps;
                bf16x8 pf[2];
#pragma unroll
                for (int s = 0; s < 2; ++s) {
                    const u32x4 w = {pk2(S[8 * s + 0], S[8 * s + 1]), pk2(S[8 * s + 2], S[8 * s + 3]), pk2(S[8 * s + 4], S[8 * s + 5]), pk2(S[8 * s + 6], S[8 * s + 7])};
                    pf[s] = __builtin_bit_cast(bf16x8, w);
                }
#pragma unroll
                for (int dt = 0; dt < DV / 32; ++dt) {
                    if (DV > 64) asm volatile("" ::: "memory");
#pragma unroll
                    for (int s = 0; s < 2; ++s) {
                        const s16x4 lo = __builtin_amdgcn_ds_read_tr16_b64_v4i16((LDS s16x4*)(vb + voff + (st * 32 + s * 16) * VSTR + dt * 64));
                        const s16x4 hi = __builtin_amdgcn_ds_read_tr16_b64_v4i16((LDS s16x4*)(vb + voff + (st * 32 + s * 16 + 8) * VSTR + dt * 64));
                        const bf16x8 a = __builtin_shufflevector(lo, hi, 0, 1, 2, 3, 4, 5, 6, 7);
                        O[dt] = MFMA(a, pf[s], O[dt]);
                    }
                }
            }
        }
        if (kt + 1 < ntiles) { late_v(kt + 1); stash((kt + 1) & 1); }
        __syncthreads();
    }
    l_out = l + __shfl_xor(l, 32);
}

DI int next_unit(unsigned* ctr) {
    LDS int* su = (LDS int*)((LDS char*)smem + 65528);
    if (TIDX == 0) *su = (int)atomicAdd(ctr, 1u);
    __syncthreads();
    const int u = *su;
    __syncthreads();
    return u;
}

DI int attn_unit(unsigned* ctr, int iter) {
    if (gridDim.x == 256) {
        if (iter < 4) {
            const int g = blockIdx.x >> 6, sh = blockIdx.x & 63;
            const int qb = (iter == 0) ? 15 - g : (iter == 1) ? 8 + g : (iter == 2) ? 7 - g : g;
            return 128 + (15 - qb) * 64 + sh;
        }
        const int u = next_unit(ctr);
        return u < 128 ? u : -1;
    }
    const int u = next_unit(ctr);
    return u < 128 + 1024 ? u : -1;
}

DI void unit_decode(int u, int& samp, int& s, int& h, int& qb) {
    if (u < 128) { samp = 1; s = u >> 3; h = u & 7; qb = 0; }
    else { const int v = u - 128; samp = 0; qb = 15 - (v >> 6); s = (v & 63) >> 3; h = v & 7; }
}

DI void phase_fox_attn(const Params& P, unsigned* ctr) {
    const bf16_t* QE = (const bf16_t*)(P.ws + R_QE);
    bf16_t* MIX = (bf16_t*)(P.ws + OFF_HN);
    const int lane = TIDX & 63, wave = TIDX >> 6, r = lane & 31, hh = lane >> 5;
    for (int iter = 0;; ++iter) {
        const int u = attn_unit(ctr, iter);
        if (u < 0) break;
        int samp, s, h, qb; unit_decode(u, samp, s, h, qb);
        const bf16_t *Qb, *Kb, *Vb; const float* cb; int nq, past, kvlen, row0;
        if (!samp) {
            row0 = s * 4096; nq = 4096; past = 0; kvlen = 4096;
            Kb = (const bf16_t*)(P.ws + R_KE) + (size_t)row0 * 512 + h * 64; Vb = (const bf16_t*)(P.ws + R_VE) + (size_t)row0 * 512 + h * 64;
            cb = (const float*)(P.ws + R_CBP) + (size_t)(s * 8 + h) * 4096;
        } else {
            row0 = MP + s * 16; nq = 16; past = 1024; kvlen = 1040;
            Kb = (const bf16_t*)(P.ws + OFF_KS) + (size_t)s * KVS * 512 + h * 64; Vb = (const bf16_t*)(P.ws + OFF_VS) + (size_t)s * KVS * 512 + h * 64;
            cb = (const float*)(P.ws + R_CBS) + (size_t)(s * 8 + h) * KVS;
        }
        Qb = QE + (size_t)row0 * 512 + h * 64;
        f32x16 O[2]; float l;
        flash_pass<64, true>(Qb, 512, Kb, 512, Vb, 512, cb, qb * 256, nq, past, 0, kvlen, O, l);
        const int qi = qb * 256 + wave * 32 + r;
        if (qi < nq) {
            const float inv = 1.0f / l;
            bf16_t* dst = MIX + (size_t)(row0 + qi) * 1024 + 512 + h * 64;
#pragma unroll
            for (int dt = 0; dt < 2; ++dt)
#pragma unroll
                for (int g = 0; g < 4; ++g)
                    *(u32x2*)(dst + dt * 32 + 8 * g + 4 * hh) = (u32x2){pk2(O[dt][4 * g] * inv, O[dt][4 * g + 1] * inv), pk2(O[dt][4 * g + 2] * inv, O[dt][4 * g + 3] * inv)};
        }
    }
}

DI void phase_diff_attn(const Params& P, int o, int layer, unsigned* ctr) {
    const bf16_t* QO = (const bf16_t*)(P.ws + R_QO);
    float* O1 = (float*)(P.ws + R_O1);
    bf16_t* MIX = (bf16_t*)(P.ws + OFF_HN);
    const int lane = TIDX & 63, wave = TIDX >> 6, r = lane & 31, hh = lane >> 5;
    const float lam_init = 0.8f - 0.6f * expf(-0.3f * (float)layer);
    const float* lp = P.in[I_DLAM] + o * 256;
    const float s1 = wave_sum(lp[lane] * lp[64 + lane]), s2 = wave_sum(lp[128 + lane] * lp[192 + lane]);
    const float lam = expf(s1) - expf(s2) + lam_init;
    const float* sg = P.in[I_SUBG] + o * 128;
    for (int iter = 0;; ++iter) {
        const int u = attn_unit(ctr, iter);
        if (u < 0) break;
        int samp, s, h, qb; unit_decode(u, samp, s, h, qb);
        const bf16_t *Kb, *Vb; int nq, past, kvlen, row0;
        if (!samp) {
            row0 = s * 4096; nq = 4096; past = 0; kvlen = 4096;
            Kb = (const bf16_t*)(P.ws + R_KO) + (size_t)row0 * 1024 + h * 128; Vb = (const bf16_t*)(P.ws + R_VO) + (size_t)row0 * 1024 + h * 128;
        } else {
            row0 = MP + s * 16; nq = 16; past = 1024; kvlen = 1040;
            Kb = (const bf16_t*)(P.ws + OFF_KS) + (size_t)s * KVS * 1024 + h * 128; Vb = (const bf16_t*)(P.ws + OFF_VS) + (size_t)s * KVS * 1024 + h * 128;
        }
        const bf16_t* Qb = QO + (size_t)row0 * 1024 + h * 128;
        const int qi = qb * 256 + wave * 32 + r;
        const unsigned rowc = (unsigned)(row0 + (qi < nq ? qi : nq - 1));
        const unsigned o1off = (rowc * 1024u + (unsigned)(h * 128 + 4 * hh)) * 4u;
        const unsigned mixoff = (rowc * 1024u + (unsigned)(h * 128 + 4 * hh)) * 2u;
        for (int c = 0; c < 2; ++c) {
            f32x16 O[4]; float l;
            flash_pass<128, false>(Qb + c * 64, 1024, Kb + c * 64, 1024, Vb, 1024, nullptr, qb * 256, nq, past, 1, kvlen, O, l);
            if (qi < nq) {
                const float inv = 1.0f / l;
                char* o1p = (char*)O1 + o1off;
                if (c == 0) {
#pragma unroll
                    for (int dt = 0; dt < 4; ++dt)
#pragma unroll
                        for (int g = 0; g < 4; ++g)
                            *(f32x4*)(o1p + (dt * 32 + 8 * g) * 4) = (f32x4){O[dt][4 * g] * inv, O[dt][4 * g + 1] * inv, O[dt][4 * g + 2] * inv, O[dt][4 * g + 3] * inv};
                } else {
                    float ss = 0.f;
                    const float nl = -lam * inv;
#pragma unroll
                    for (int dt = 0; dt < 4; ++dt)
#pragma unroll
                        for (int i = 0; i < 16; ++i) O[dt][i] *= nl;
#pragma unroll
                    for (int dt = 0; dt < 4; ++dt) {
#pragma unroll
                        for (int g = 0; g < 4; ++g) {
                            const f32x4 a = *(const f32x4*)(o1p + (dt * 32 + 8 * g) * 4);
#pragma unroll
                            for (int j = 0; j < 4; ++j) { const float v = a[j] + O[dt][4 * g + j]; O[dt][4 * g + j] = v; ss += v * v; }
                        }
                        asm volatile("" : "+v"(ss) :: "memory");
                    }
                    ss += __shfl_xor(ss, 32);
                    const float rstd = rsqrtf(ss * (1.0f / 128.0f) + EPSN) * (1.0f - lam_init);
                    char* dst = (char*)MIX + mixoff;
                    const char* sgp = (const char*)sg + hh * 16;
#pragma unroll
                    for (int dt = 0; dt < 4; ++dt) {
                        asm volatile("" ::: "memory");
#pragma unroll
                        for (int g = 0; g < 4; ++g) {
                            const f32x4 gg = *(const f32x4*)(sgp + (dt * 32 + 8 * g) * 4);
                            *(u32x2*)(dst + (dt * 32 + 8 * g) * 2) = (u32x2){pk2(O[dt][4 * g] * rstd * gg.x, O[dt][4 * g + 1] * rstd * gg.y), pk2(O[dt][4 * g + 2] * rstd * gg.z, O[dt][4 * g + 3] * rstd * gg.w)};
                        }
                        asm volatile("" ::: "memory");
                    }
                }
            }
        }
    }
}


#define XB_TMO      128
#define XB_XCNT(j)  (256  + 64 * (j))
#define XB_XSUB(j)  (1280 + 64 * (j))
#define XB_XGEN(j)  (2304 + 64 * (j))
#define XB_TOP      3328
#define XB_TOPGEN   3392
#define XCD_BAR_WORDS 3456
#define XB_SPIN_CAP (1u << 22)
DI unsigned xb_ld(unsigned* p) { return __hip_atomic_load(p, __ATOMIC_RELAXED, __HIP_MEMORY_SCOPE_AGENT); }
DI unsigned xb_add(unsigned* p, unsigned v) { return __hip_atomic_fetch_add(p, v, __ATOMIC_RELAXED, __HIP_MEMORY_SCOPE_AGENT); }
DI unsigned xb_xcc_id() { return (unsigned)__builtin_amdgcn_s_getreg((3 << 11) | 20) & 0xFu; }
#define XB_SPIN(cond, bar) do { unsigned _sp = 0; while (cond) { __builtin_amdgcn_s_sleep(1); \
    if ((++_sp & 255u) == 0u) { if (xb_ld(&(bar)[XB_TMO])) break; if (_sp > XB_SPIN_CAP) { atomicAdd(&(bar)[XB_TMO], 1u); break; } } } } while (0)
__shared__ __attribute__((aligned(16))) unsigned xb_words[4];
struct XcdBarrier { unsigned* bar; unsigned x; };
DI XcdBarrier xcd_barrier_post(unsigned* bar) {
    XcdBarrier b; b.bar = bar; b.x = xb_xcc_id();
    if (threadIdx.x == 0) (void)xb_add(&bar[XB_XCNT(b.x)], 1u);
    return b;
}
DI void xcd_barrier_complete(unsigned* bar, unsigned x, unsigned& nloc, unsigned& nx) {
    const unsigned G = gridDim.x * gridDim.y * gridDim.z;
    unsigned sum, cnt, mine, sp = 0u;
    for (;;) {
        sum = 0u; cnt = 0u; mine = 0u;
#pragma unroll
        for (unsigned j = 0; j < 16; ++j) { const unsigned c = xb_ld(&bar[XB_XCNT(j)]); sum += c; cnt += (c > 0u) ? 1u : 0u; mine = (j == x) ? c : mine; }
        if (sum == G) break;
        __builtin_amdgcn_s_sleep(1);
        if ((++sp & 255u) == 0u) { if (xb_ld(&bar[XB_TMO])) break; if (sp > XB_SPIN_CAP) { atomicAdd(&bar[XB_TMO], 1u); break; } }
    }
    nloc = mine > 0u ? mine : 1u; nx = cnt > 0u ? cnt : 1u;
}
DI void xcd_barrier(const XcdBarrier& b) {
    volatile LDS unsigned* st = (volatile LDS unsigned*)xb_words;
    asm volatile("s_waitcnt vmcnt(0)" ::: "memory");
    __syncthreads();
    if (threadIdx.x == 0) {
        unsigned* bar = b.bar;
        __builtin_amdgcn_s_waitcnt(0);
        unsigned nloc = st[0], nx = st[1];
        if (nloc == 0u) { xcd_barrier_complete(bar, b.x, nloc, nx); st[0] = nloc; st[1] = nx; }
        const unsigned old = xb_add(&bar[XB_XSUB(b.x)], 1u);
        const unsigned gen = old / nloc;
        if (old + 1u == (gen + 1u) * nloc) {
            __builtin_amdgcn_fence(__ATOMIC_RELEASE, "agent");
            asm volatile("s_waitcnt vmcnt(0)" ::: "memory");
            const unsigned og = xb_add(&bar[XB_TOP], 1u);
            const unsigned tg = og / nx;
            if (og + 1u == (tg + 1u) * nx) xb_add(&bar[XB_TOPGEN], 1u);
            else XB_SPIN(xb_ld(&bar[XB_TOPGEN]) == tg, bar);
            __builtin_amdgcn_fence(__ATOMIC_ACQUIRE, "agent");
            xb_add(&bar[XB_XGEN(b.x)], 1u);
            asm volatile("s_waitcnt vmcnt(0)" ::: "memory");
        } else {
            XB_SPIN(xb_ld(&bar[XB_XGEN(b.x)]) == gen, bar);
            __builtin_amdgcn_fence(__ATOMIC_ACQUIRE, "agent");
            asm volatile("s_waitcnt vmcnt(0)" ::: "memory");
        }
    }
    __syncthreads();
}

constexpr int NPHASE = 45;
DI void run_phase(const Params& P, int ph) {
    unsigned* ctrl = (unsigned*)(P.ws + OFF_CTRL);
    if (ph == 0) {
        phase_prologue(P);
        phase_norm(P, 0, 0.f, nullptr, P.in[I_NG]);
        return;
    }
    int q = ph - 1, l, st;
    if (q < 12) { l = 0; st = q; } else if (q < 22) { l = 1; st = q - 12; } else if (q < 34) { l = 2; st = q - 22; } else { l = 3; st = q - 34; }
    const bool even = (l & 1) == 0; const int li = l >> 1;
    const float* ng = P.in[I_NG] + (size_t)l * 6 * DM;
    const bf16_t* HN = (const bf16_t*)(P.ws + OFF_HN);
    bf16_t* OUT = (bf16_t*)(P.ws + OFF_OUT);
    bf16_t* ACT = (bf16_t*)(P.ws + R_ACT);
    const bf16_t* wfi = (const bf16_t*)(P.ws + OFF_WT_FFN_IN); const bf16_t* wfo = (const bf16_t*)(P.ws + OFF_WT_FFN_OUT);
    const int nst = even ? 12 : 10;
    if (st == 0 || st == nst - 3) {
        const int f = (st == 0) ? 0 : 1;
        GemmArgs g{HN, DM, 0, wfi + (size_t)(l * 2 + f) * 5632 * 1024, 1024, 128, 22, 88, 0};
        gemm_phase<EPI_SWIGLU>(P, 0, g, ACT, DFF);
    } else if (st == 1 || st == nst - 2) {
        const int f = (st == 1) ? 0 : 1;
        GemmArgs g{ACT, DFF, 0, wfo + (size_t)(l * 2 + f) * 1024 * DFF, DFF, 128, 4, 88, 2};
        gemm_phase<EPI_PLAIN>(P, 0, g, OUT, DM);
    } else if (st == 2) {
        phase_norm(P, 1, 0.5f, ng + 1 * DM, ng + 2 * DM);
        if (even) cache_prep(P.in[I_CFK] + (size_t)li * 16 * 1024 * 512, P.in[I_CFV] + (size_t)li * 16 * 1024 * 512, (bf16_t*)(P.ws + OFF_KS), (bf16_t*)(P.ws + OFF_VS), 512);
        else cache_prep(P.in[I_CDK] + (size_t)li * 16 * 1024 * 1024, P.in[I_CDV] + (size_t)li * 16 * 1024 * 1024, (bf16_t*)(P.ws + OFF_KS), (bf16_t*)(P.ws + OFF_VS), 1024);
    } else if (st == nst - 1) {
        phase_norm(P, 1, 0.5f, ng + 5 * DM, (l < 3) ? ng + 6 * DM : nullptr);
    } else if (st == nst - 4) {
        phase_norm(P, 1, 1.0f, ng + 3 * DM, ng + 4 * DM);
    } else if (st == nst - 5) {
        const bf16_t* wo = even ? (const bf16_t*)(P.ws + OFF_WT_OUT_EVEN) : (const bf16_t*)(P.ws + OFF_WT_OUT_ODD);
        GemmArgs g{HN, DM, 0, wo + (size_t)li * 1024 * 1024, 1024, 128, 4, 32, 2};
        gemm_phase<EPI_PLAIN>(P, 0, g, OUT, DM);
    } else if (even) {
        if (st == 3) {
            GemmArgs g{HN, DM, 0, (const bf16_t*)(P.ws + OFF_WT_IN_EVEN) + (size_t)li * 2816 * 1024, 1024, 129, 11, 0, 0};
            gemm_phase<EPI_EVEN_IN>(P, li, g, nullptr, 0);
        } else if (st == 4) {
            phase_conv(P, li);
        } else if (st == 5) {
            GemmArgs g{(const bf16_t*)(P.ws + R_UC), 512, 128, (const bf16_t*)(P.ws + OFF_WT_GATES) + (size_t)li * 4 * 256 * 128, 128, 129, 4, 0, 0};
            gemm_phase<EPI_GATES>(P, li, g, nullptr, 0);
        } else if (st == 6) {
            phase_scan3(P, li);
            phase_fox_attn(P, ctrl + 16 * l);
        }
    } else {
        if (st == 3) {
            GemmArgs g{HN, DM, 0, (const bf16_t*)(P.ws + OFF_WT_IN_ODD) + (size_t)li * 3072 * 1024, 1024, 128, 12, 48, 0};
            gemm_phase<EPI_ODD_IN>(P, li, g, nullptr, 0);
        } else if (st == 4) {
            phase_diff_attn(P, li, l, ctrl + 16 * l);
        }
    }
}

#if MULTI_LAUNCH
__global__ void __launch_bounds__(512, 2) phase_kernel(Params P, int ph) { run_phase(P, ph); }
#else
__global__ void __launch_bounds__(512, 2) mega_kernel(Params P) {
    cg::grid_group grid = cg::this_grid();
    if (threadIdx.x < 4) xb_words[threadIdx.x] = 0u;
    __syncthreads();
    const XcdBarrier xb = xcd_barrier_post((unsigned*)(P.ws + OFF_BAR));
    for (int ph = 0; ph < NPHASE; ++ph) {
        run_phase(P, ph);
        if (ph == 0) grid.sync();
        else if (ph + 1 < NPHASE) xcd_barrier(xb);
    }
}
#endif

extern "C" void kernel_launch(void* const* d_in, const int* in_sizes, int n_in, void* d_out, int out_size, void* d_ws, size_t ws_size,
                              hipStream_t stream) {
    Params p{};
    for (int i = 0; i < 24; ++i) p.in[i] = (const float*)d_in[i];
    p.out = (float*)d_out; p.ws = (char*)d_ws;
    if (ws_size < WS_NEEDED) fprintf(stderr, "workspace too small: %zu < %zu\n", ws_size, (size_t)WS_NEEDED);
    hipMemsetAsync(d_ws, 0, 20480, stream);
    static int grid_blocks = 0;
    if (!grid_blocks) {
        int dev = 0, cus = 0, per_cu = 0;
        hipGetDevice(&dev);
        hipDeviceGetAttribute(&cus, hipDeviceAttributeMultiprocessorCount, dev);
#if MULTI_LAUNCH
        hipOccupancyMaxActiveBlocksPerMultiprocessor(&per_cu, phase_kernel, NT, 0);
#else
        hipOccupancyMaxActiveBlocksPerMultiprocessor(&per_cu, mega_kernel, NT, 0);
#endif
        if (per_cu < 1) per_cu = 1;
        if (per_cu > 1) per_cu = 1;
        grid_blocks = cus * per_cu;
    }
#if MULTI_LAUNCH
    for (int ph = 0; ph < NPHASE; ++ph) phase_kernel<<<grid_blocks, NT, 0, stream>>>(p, ph);
#else
    void* args[] = {&p};
    hipError_t e = hipLaunchCooperativeKernel((void*)mega_kernel, dim3(grid_blocks), dim3(NT), args, 0, stream);
    if (e != hipSuccess) fprintf(stderr, "cooperative launch failed: %s (grid %d)\n", hipGetErrorString(e), grid_blocks);
#endif
}
```
